# Optimizing an MI355X kernel written in HIP

```python
import jax, jax.numpy as jnp
from jax import lax
import numpy as np

D_MODEL = 1024
BATCH = 8
SEQ = 4096
DEPTH = 2

GRID_W = 64
N_META = 16
HEAD_DIM = 64
ATTN_HEADS = 8
ATTN_KV_HEADS = 2
ATTN_GROUP = ATTN_HEADS // ATTN_KV_HEADS
ATTN_WIDTH = ATTN_HEADS * HEAD_DIM
ATTN_KV_WIDTH = ATTN_KV_HEADS * HEAD_DIM
NA_HEADS = 8
NA_WIDTH = NA_HEADS * HEAD_DIM
NA_KH_MAX = 8
NA_KW = 16
Q_BLOCK = 128
ROPE_THETA = 10000.0
EPS = 1e-6
IN_SPLITS = (ATTN_WIDTH, ATTN_KV_WIDTH, ATTN_KV_WIDTH, ATTN_WIDTH,
             NA_WIDTH, NA_WIDTH, NA_WIDTH, NA_WIDTH, D_MODEL, D_MODEL)
IN_COLS = ATTN_WIDTH * 2 + ATTN_KV_WIDTH * 2 + NA_WIDTH * 4 + D_MODEL * 2

kernel_name = "hybrid_gqa_natten_gated_encoder"


def rms_norm(x, g):
    xf = x.astype(jnp.float32)
    y = xf * lax.rsqrt(jnp.mean(xf * xf, axis=-1, keepdims=True) + EPS)
    return (y * g.astype(jnp.float32)).astype(x.dtype)


def split_cols(p):
    outs, off = [], 0
    for w in IN_SPLITS:
        outs.append(p[..., off:off + w])
        off += w
    return outs


def axial_rope_tables(n_real):
    t = jnp.arange(n_real, dtype=jnp.int32)
    zeros = jnp.zeros((N_META,), jnp.int32)
    row = jnp.concatenate([zeros, t // GRID_W]).astype(jnp.float32)
    col = jnp.concatenate([zeros, t % GRID_W]).astype(jnp.float32)
    axis_dim = HEAD_DIM // 2
    inv = ROPE_THETA ** (-jnp.arange(0, axis_dim, 2, dtype=jnp.float32) / axis_dim)
    ang_r = row[:, None] * inv[None]
    ang_c = col[:, None] * inv[None]
    ang = jnp.concatenate([ang_r, ang_r, ang_c, ang_c], axis=-1)
    return jnp.cos(ang), jnp.sin(ang)


def apply_axial_rope(x, cos, sin):
    axis_dim = HEAD_DIM // 2
    q4 = axis_dim // 2
    xf = x.astype(jnp.float32)
    xr, xc = xf[..., :axis_dim], xf[..., axis_dim:]
    rot = jnp.concatenate([-xr[..., q4:], xr[..., :q4], -xc[..., q4:], xc[..., :q4]], axis=-1)
    return (xf * cos[None, :, None, :] + rot * sin[None, :, None, :]).astype(x.dtype)


def gqa_attention(q, k, v):
    b, l = q.shape[:2]
    n = l - N_META
    scale = HEAD_DIM ** -0.5

    def attend(qb):
        s = jnp.einsum('bqkgd,bskd->bkgqs', qb, k).astype(jnp.float32) * scale
        p = jax.nn.softmax(s, axis=-1).astype(v.dtype)
        return jnp.einsum('bkgqs,bskd->bqkgd', p, v)

    qg = q.reshape(b, l, ATTN_KV_HEADS, ATTN_GROUP, HEAD_DIM)
    o_meta = attend(qg[:, :N_META])
    q_blocks = qg[:, N_META:].reshape(b, n // Q_BLOCK, Q_BLOCK, ATTN_KV_HEADS, ATTN_GROUP, HEAD_DIM)
    q_blocks = q_blocks.transpose(1, 0, 2, 3, 4, 5)
    o_real = lax.map(attend, q_blocks).transpose(1, 0, 2, 3, 4, 5)
    o_real = o_real.reshape(b, n, ATTN_KV_HEADS, ATTN_GROUP, HEAD_DIM)
    return jnp.concatenate([o_meta, o_real], axis=1).reshape(b, l, ATTN_WIDTH)


def neighbourhood_attention(q, k, v, rpb):
    b, l = q.shape[:2]
    n = l - N_META
    rows = n // GRID_W
    kh = min(NA_KH_MAX, rows)
    scale = HEAD_DIM ** -0.5
    qm, km, vm = q[:, :N_META], k[:, :N_META], v[:, :N_META]

    s_mm = jnp.einsum('bqhd,bmhd->bhqm', qm, km).astype(jnp.float32) * scale
    o_meta = jnp.einsum('bhqm,bmhd->bqhd', jax.nn.softmax(s_mm, axis=-1).astype(v.dtype), vm)

    qg = q[:, N_META:].reshape(b, rows, GRID_W, NA_HEADS, HEAD_DIM)
    kg = k[:, N_META:].reshape(b, rows, GRID_W, NA_HEADS, HEAD_DIM)
    vg = v[:, N_META:].reshape(b, rows, GRID_W, NA_HEADS, HEAD_DIM)

    r = jnp.arange(rows)
    row_start = jnp.clip(r - kh // 2, 0, rows - kh)
    row_bias_idx = row_start[:, None] + jnp.arange(kh)[None] - r[:, None] + NA_KH_MAX - 1
    c = jnp.arange(GRID_W)
    col_start = jnp.clip(c - NA_KW // 2, 0, GRID_W - NA_KW)
    col_idx = col_start[:, None] + jnp.arange(NA_KW)[None]
    col_bias_idx = col_idx - c[:, None] + NA_KW - 1
    rpb_cols = rpb[:, :, col_bias_idx]

    def row_step(args):
        q_row, rs, rbi = args
        k_band = lax.dynamic_slice_in_dim(kg, rs, kh, axis=1)
        v_band = lax.dynamic_slice_in_dim(vg, rs, kh, axis=1)
        k_win = k_band[:, :, col_idx]
        v_win = v_band[:, :, col_idx]
        s_win = jnp.einsum('bchd,bicjhd->bhcij', q_row, k_win).astype(jnp.float32) * scale
        bias = rpb_cols[:, rbi].transpose(0, 2, 1, 3)
        s_win = s_win + bias[None].astype(jnp.float32)
        s_meta = jnp.einsum('bchd,bmhd->bhcm', q_row, km).astype(jnp.float32) * scale
        s = jnp.concatenate([s_win.reshape(b, NA_HEADS, GRID_W, kh * NA_KW), s_meta], axis=-1)
        p = jax.nn.softmax(s, axis=-1).astype(v.dtype)
        p_win = p[..., :kh * NA_KW].reshape(b, NA_HEADS, GRID_W, kh, NA_KW)
        p_meta = p[..., kh * NA_KW:]
        return (jnp.einsum('bhcij,bicjhd->bchd', p_win, v_win)
                + jnp.einsum('bhcm,bmhd->bchd', p_meta, vm))

    o_rows = lax.map(row_step, (qg.transpose(1, 0, 2, 3, 4), row_start, row_bias_idx))
    o_real = o_rows.transpose(1, 0, 2, 3, 4).reshape(b, n, NA_WIDTH)
    return jnp.concatenate([o_meta.reshape(b, N_META, NA_WIDTH), o_real], axis=1)


def hybrid_layer(x, norm_g, w_in, q_norm_g, k_norm_g, rpb, w_o_attn, w_o_na, w_out, cos, sin):
    b, l, _ = x.shape
    h = rms_norm(x, norm_g)
    proj = jnp.einsum('bld,de->ble', h, w_in)
    qa, ka, va, za, qb, kb, vb, zb, ga, gb = split_cols(proj)

    qa = apply_axial_rope(rms_norm(qa.reshape(b, l, ATTN_HEADS, HEAD_DIM), q_norm_g), cos, sin)
    ka = apply_axial_rope(rms_norm(ka.reshape(b, l, ATTN_KV_HEADS, HEAD_DIM), k_norm_g), cos, sin)
    va = va.reshape(b, l, ATTN_KV_HEADS, HEAD_DIM)
    oa = gqa_attention(qa, ka, va) * jax.nn.silu(za)

    qb = qb.reshape(b, l, NA_HEADS, HEAD_DIM)
    kb = kb.reshape(b, l, NA_HEADS, HEAD_DIM)
    vb = vb.reshape(b, l, NA_HEADS, HEAD_DIM)
    ob = neighbourhood_attention(qb, kb, vb, rpb) * jax.nn.silu(zb)

    ya = jnp.einsum('ble,ed->bld', oa, w_o_attn)
    yb = jnp.einsum('ble,ed->bld', ob, w_o_na)
    mixed = jax.nn.sigmoid(ga) * ya + jax.nn.sigmoid(gb) * yb
    return x + jnp.einsum('bld,de->ble', mixed, w_out)


def setup_inputs(seed: int = 0) -> dict:
    key = jax.random.key(seed)
    ks = jax.random.split(key, 12)
    f32 = jnp.float32
    x = jax.random.normal(ks[0], (BATCH, SEQ, D_MODEL), f32)
    meta_tokens = jax.random.normal(ks[1], (N_META, D_MODEL), f32)
    norm_g = 1.0 + 0.05 * jax.random.normal(ks[2], (DEPTH, D_MODEL), f32)
    w_in = jax.random.normal(ks[3], (DEPTH, D_MODEL, IN_COLS), f32) * D_MODEL ** -0.5
    q_norm_g = 1.0 + 0.05 * jax.random.normal(ks[4], (DEPTH, HEAD_DIM), f32)
    k_norm_g = 1.0 + 0.05 * jax.random.normal(ks[5], (DEPTH, HEAD_DIM), f32)
    na_rpb = 0.1 * jax.random.normal(ks[6], (DEPTH, NA_HEADS, 2 * NA_KH_MAX - 1, 2 * NA_KW - 1), f32)
    w_o_attn = jax.random.normal(ks[7], (DEPTH, ATTN_WIDTH, D_MODEL), f32) * ATTN_WIDTH ** -0.5
    w_o_na = jax.random.normal(ks[8], (DEPTH, NA_WIDTH, D_MODEL), f32) * NA_WIDTH ** -0.5
    w_out = jax.random.normal(ks[9], (DEPTH, D_MODEL, D_MODEL), f32) * D_MODEL ** -0.5
    final_norm_g = 1.0 + 0.05 * jax.random.normal(ks[10], (D_MODEL,), f32)
    return {"x": x, "meta_tokens": meta_tokens, "norm_g": norm_g, "w_in": w_in,
            "q_norm_g": q_norm_g, "k_norm_g": k_norm_g, "na_rpb": na_rpb,
            "w_o_attn": w_o_attn, "w_o_na": w_o_na, "w_out": w_out,
            "final_norm_g": final_norm_g}


def reference(x, meta_tokens, norm_g, w_in, q_norm_g, k_norm_g, na_rpb, w_o_attn, w_o_na, w_out, final_norm_g):
    b, s, _ = x.shape
    meta = jnp.broadcast_to(meta_tokens[None].astype(x.dtype), (b, N_META, D_MODEL))
    h = jnp.concatenate([meta, x], axis=1)
    cos, sin = axial_rope_tables(s)
    for i in range(DEPTH):
        h = hybrid_layer(h, norm_g[i], w_in[i], q_norm_g[i], k_norm_g[i], na_rpb[i],
                         w_o_attn[i], w_o_na[i], w_out[i], cos, sin)
    h = rms_norm(h, final_norm_g)
    return h[:, N_META:]
```

```cpp
#include <hip/hip_runtime.h>
#include <cstdio>
#include <cstdint>
#include <cmath>

typedef unsigned short bf16_t;
typedef short bf16x8 __attribute__((ext_vector_type(8)));
typedef float f32x4 __attribute__((ext_vector_type(4)));
typedef unsigned u32x4 __attribute__((ext_vector_type(4)));
typedef unsigned u32x2 __attribute__((ext_vector_type(2)));

constexpr int DM = 1024, NB = 8, SEQ = 4096, NMETA = 16;
constexpr int NREAL = NB * SEQ;
constexpr int NTOK = NREAL + NB * NMETA;
constexpr int MPAD = 33024;
constexpr int INC = 5376;
constexpr int KVROWS = 4160;
constexpr float EPS = 1e-6f;
constexpr float LOG2E = 1.4426950408889634f;
constexpr float C2 = 0.125f * LOG2E;
constexpr int C_QA = 0, C_KA = 512, C_VA = 640, C_ZA = 768, C_QB = 1280, C_KB = 1792, C_VB = 2304, C_ZB = 2816, C_GA = 3328, C_GB = 4352;

constexpr size_t MiB = 1u << 20;
constexpr size_t WS_CTL = 0, WS_ROPE = 1 * MiB, WS_HM = 3 * MiB;
constexpr size_t WS_WIN_N = 4 * MiB, WS_WIN_P = 25 * MiB, WS_WOA = 46 * MiB, WS_WOB = 48 * MiB, WS_WOUT = 50 * MiB, WS_WOC = 54 * MiB, WS_WOUT_P = 58 * MiB;
constexpr size_t WS_XN = 62 * MiB, WS_QA = 127 * MiB, WS_QB = 160 * MiB, WS_MIX = 127 * MiB;
constexpr size_t WS_Z = 193 * MiB, WS_KA = 258 * MiB, WS_VA = 267 * MiB, WS_KB = 276 * MiB, WS_VB = 309 * MiB;
constexpr size_t WS_GA = 342 * MiB, WS_GB = 407 * MiB, WS_ROWP = 472 * MiB, WS_END = 479 * MiB;

__device__ __forceinline__ unsigned f2bf(float f) { unsigned u = __builtin_bit_cast(unsigned, f); return (u + 0x7fffu + ((u >> 16) & 1u)) >> 16; }
__device__ __forceinline__ float bf2f(unsigned h) { return __builtin_bit_cast(float, h << 16); }
__device__ __forceinline__ unsigned pk2(float lo, float hi) { return f2bf(lo) | (f2bf(hi) << 16); }
__device__ __forceinline__ float wave_sum(float v) {
#pragma unroll
    for (int o = 1; o < 64; o <<= 1) v += __shfl_xor(v, o);
    return v;
}
__device__ __forceinline__ float sigmoidf_(float x) { return 1.f / (1.f + __expf(-x)); }

struct RowInfo { int b, lp, gy, gx; bool valid; };
__device__ __forceinline__ RowInfo row_info(int r) {
    RowInfo i;
    if (r < NREAL) { i.b = r >> 12; const int s = r & 4095; i.lp = 64 + s; i.gy = s >> 6; i.gx = s & 63; i.valid = true; }
    else { const int q = r - NREAL; i.b = (q >> 4) & 7; i.lp = q & 15; i.gy = 0; i.gx = 0; i.valid = r < NTOK; }
    return i;
}

__global__ void __launch_bounds__(256) k_transpose(const float* __restrict__ W, bf16_t* __restrict__ Wt, int K, int N) {
    __shared__ float tile[32][33];
    const int n0 = blockIdx.x * 32, k0 = blockIdx.y * 32, tx = threadIdx.x & 31, ty = threadIdx.x >> 5;
#pragma unroll
    for (int i = 0; i < 4; ++i) tile[ty + 8 * i][tx] = W[(size_t)(k0 + ty + 8 * i) * N + n0 + tx];
    __syncthreads();
#pragma unroll
    for (int i = 0; i < 4; ++i) Wt[(size_t)(n0 + ty + 8 * i) * K + k0 + tx] = (bf16_t)f2bf(tile[tx][ty + 8 * i]);
}
__global__ void __launch_bounds__(256) k_misc(float* rope, bf16_t* KA, bf16_t* VA, bf16_t* KB, bf16_t* VB, bf16_t* XN, bf16_t* Z, float* rowss) {
    const int gt = blockIdx.x * 256 + threadIdx.x, nt = gridDim.x * 256;
    for (int i = gt; i < 64 * 16; i += nt) { const int pos = i >> 4, k = i & 15; const float inv = powf(10000.f, -(float)k / 16.f); const float a = (float)pos * inv; rope[i] = cosf(a); rope[1024 + i] = sinf(a); }
    for (int i = gt; i < NB * 2 * 3072; i += nt) { const int hh = i / 3072, e = i % 3072; KA[(size_t)hh * KVROWS * 64 + 1024 + e] = 0; VA[(size_t)hh * KVROWS * 64 + 1024 + e] = 0; }
    for (int i = gt; i < NB * 8 * 3072; i += nt) { const int hh = i / 3072, e = i % 3072; KB[(size_t)hh * KVROWS * 64 + 1024 + e] = 0; VB[(size_t)hh * KVROWS * 64 + 1024 + e] = 0; }
    for (int i = gt; i < (MPAD - NTOK) * 1024; i += nt) XN[(size_t)NTOK * 1024 + i] = 0;
    for (int i = gt; i < (MPAD - NTOK) * 1024; i += nt) Z[(size_t)NTOK * 1024 + i] = 0;
    for (int i = gt; i < 3 * (MPAD - NTOK) * 16; i += nt) { const int st = i / ((MPAD - NTOK) * 16), e = i % ((MPAD - NTOK) * 16); rowss[((size_t)st * MPAD + NTOK) * 16 + e] = (e & 15) ? 0.f : 1024.f; }
}
__global__ void __launch_bounds__(256) k_rownorm(const float* __restrict__ hreal, const float* __restrict__ hmeta, int meta_bcast, const float* __restrict__ g, bf16_t* __restrict__ XN, float* __restrict__ rowss) {
    const int lane = threadIdx.x & 63, r = blockIdx.x * 4 + (threadIdx.x >> 6);
    if (r >= NTOK) return;
    const float* src = (r < NREAL) ? hreal + (size_t)r * DM : hmeta + (size_t)(meta_bcast ? ((r - NREAL) & 15) : (r - NREAL)) * DM;
    float ss = 0.f; f32x4 v[4];
#pragma unroll
    for (int j = 0; j < 4; ++j) { v[j] = *(const f32x4*)(src + 256 * j + 4 * lane); ss += v[j].x * v[j].x + v[j].y * v[j].y + v[j].z * v[j].z + v[j].w * v[j].w; }
    ss = wave_sum(ss);
#pragma unroll
    for (int j = 0; j < 4; ++j) { const f32x4 gg = *(const f32x4*)(g + 256 * j + 4 * lane); u32x2 o; o.x = pk2(v[j].x * gg.x, v[j].y * gg.y); o.y = pk2(v[j].z * gg.z, v[j].w * gg.w); *(u32x2*)(XN + (size_t)r * DM + 256 * j + 4 * lane) = o; }
    if (lane < 16) rowss[(size_t)r * 16 + lane] = lane ? 0.f : ss;
}
__global__ void __launch_bounds__(256) k_final(float* __restrict__ out, const float* __restrict__ g) {
    const int lane = threadIdx.x & 63, r = blockIdx.x * 4 + (threadIdx.x >> 6);
    if (r >= NREAL) return;
    float* p = out + (size_t)r * DM; float ss = 0.f; f32x4 v[4];
#pragma unroll
    for (int j = 0; j < 4; ++j) { v[j] = *(const f32x4*)(p + 256 * j + 4 * lane); ss += v[j].x * v[j].x + v[j].y * v[j].y + v[j].z * v[j].z + v[j].w * v[j].w; }
    ss = wave_sum(ss); const float rstd = rsqrtf(ss * (1.f / DM) + EPS);
#pragma unroll
    for (int j = 0; j < 4; ++j) { const f32x4 gg = *(const f32x4*)(g + 256 * j + 4 * lane); *(f32x4*)(p + 256 * j + 4 * lane) = v[j] * rstd * gg; }
}

__device__ __forceinline__ void wave_gemm(const bf16_t* __restrict__ A, int lda, const bf16_t* __restrict__ Bt, int ldb, int row0, int col0, int K, f32x4 (&acc)[4]) {
    const int lane = threadIdx.x & 63;
    const bf16_t* ap = A + (size_t)(row0 + (lane & 15)) * lda + 8 * (lane >> 4);
    const bf16_t* bp = Bt + (size_t)(col0 + (lane & 15)) * ldb + 8 * (lane >> 4);
    for (int k0 = 0; k0 < K; k0 += 32) {
        const bf16x8 a = *(const bf16x8*)(ap + k0);
#pragma unroll
        for (int n = 0; n < 4; ++n) { const bf16x8 b = *(const bf16x8*)(bp + (size_t)n * 16 * ldb + k0); acc[n] = __builtin_amdgcn_mfma_f32_16x16x32_bf16(b, a, acc[n], 0, 0, 0); }
    }
}

struct InArgs { const bf16_t* XN; const bf16_t* Wt; const float* rowss; const float* qg; const float* kg; const float* rope;
                bf16_t *QA, *KA, *VA, *Z, *QB, *KB, *VB, *GA, *GB; };
__global__ void __launch_bounds__(256) k_inproj_naive(InArgs a) {
    const int lane = threadIdx.x & 63, w = threadIdx.x >> 6, fr = lane & 15, fq = lane >> 4;
    const int c0 = blockIdx.x * 64, row0 = blockIdx.y * 64 + w * 16, r = row0 + fr;
    f32x4 acc[4] = {};
    wave_gemm(a.XN, DM, a.Wt, DM, row0, c0, DM, acc);
    const RowInfo ri = row_info(r);
    float ssr = 0.f;
#pragma unroll
    for (int i = 0; i < 16; ++i) ssr += a.rowss[(size_t)r * 16 + i];
    const float rstd = rsqrtf(ssr * (1.f / DM) + EPS);
    float x[4][4];
#pragma unroll
    for (int n = 0; n < 4; ++n)
#pragma unroll
        for (int j = 0; j < 4; ++j) x[n][j] = acc[n][j] * rstd;
    const bool is_qa = c0 < C_KA, is_ka = c0 >= C_KA && c0 < C_VA;
    if (is_qa || is_ka) {
        float ss = 0.f;
#pragma unroll
        for (int n = 0; n < 4; ++n)
#pragma unroll
            for (int j = 0; j < 4; ++j) ss += x[n][j] * x[n][j];
        ss += __shfl_xor(ss, 16); ss += __shfl_xor(ss, 32);
        const float rn = rsqrtf(ss * (1.f / 64.f) + EPS);
        const float* g = is_qa ? a.qg : a.kg;
#pragma unroll
        for (int n = 0; n < 4; ++n)
#pragma unroll
            for (int j = 0; j < 4; ++j) x[n][j] = x[n][j] * rn * g[16 * n + 4 * fq + j];
        float y[4][4];
#pragma unroll
        for (int n = 0; n < 4; ++n) {
            const int pos = (n < 2) ? ri.gy : ri.gx;
#pragma unroll
            for (int j = 0; j < 4; ++j) { const float c = a.rope[pos * 16 + 4 * fq + j], s = a.rope[1024 + pos * 16 + 4 * fq + j];
                y[n][j] = (n & 1) ? (x[n][j] * c + x[n ^ 1][j] * s) : (x[n][j] * c - x[n ^ 1][j] * s); }
        }
        const float sc = is_qa ? C2 : 1.f;
#pragma unroll
        for (int n = 0; n < 4; ++n)
#pragma unroll
            for (int j = 0; j < 4; ++j) x[n][j] = y[n][j] * sc;
    }
    if (!ri.valid) return;
    bf16_t* dst; float sc = 1.f; int mode = 0;
    if (c0 < C_KA) dst = a.QA + (size_t)r * 512 + c0;
    else if (c0 < C_VA) dst = a.KA + ((size_t)(ri.b * 2 + (c0 - C_KA) / 64) * KVROWS + ri.lp) * 64;
    else if (c0 < C_ZA) dst = a.VA + ((size_t)(ri.b * 2 + (c0 - C_VA) / 64) * KVROWS + ri.lp) * 64;
    else if (c0 < C_QB) { dst = a.Z + (size_t)r * 1024 + (c0 - C_ZA); mode = 1; }
    else if (c0 < C_KB) { dst = a.QB + (size_t)r * 512 + (c0 - C_QB); sc = C2; }
    else if (c0 < C_VB) dst = a.KB + ((size_t)(ri.b * 8 + (c0 - C_KB) / 64) * KVROWS + ri.lp) * 64;
    else if (c0 < C_ZB) dst = a.VB + ((size_t)(ri.b * 8 + (c0 - C_VB) / 64) * KVROWS + ri.lp) * 64;
    else if (c0 < C_GA) { dst = a.Z + (size_t)r * 1024 + 512 + (c0 - C_ZB); mode = 1; }
    else if (c0 < C_GB) { dst = a.GA + (size_t)r * 1024 + (c0 - C_GA); mode = 2; }
    else { dst = a.GB + (size_t)r * 1024 + (c0 - C_GB); mode = 2; }
#pragma unroll
    for (int n = 0; n < 4; ++n) {
        float v[4];
#pragma unroll
        for (int j = 0; j < 4; ++j) { float t = x[n][j] * sc; if (mode == 1) t = t * sigmoidf_(t); else if (mode == 2) t = sigmoidf_(t); v[j] = t; }
        u32x2 o; o.x = pk2(v[0], v[1]); o.y = pk2(v[2], v[3]);
        *(u32x2*)(dst + 16 * n + 4 * fq) = o;
    }
}

__global__ void __launch_bounds__(256) k_mix_naive(const bf16_t* OA, const bf16_t* OB, const bf16_t* WoA, const bf16_t* WoB, const bf16_t* GA, const bf16_t* GB, bf16_t* MIX) {
    const int lane = threadIdx.x & 63, w = threadIdx.x >> 6, fr = lane & 15, fq = lane >> 4;
    const int c0 = blockIdx.x * 64, row0 = blockIdx.y * 64 + w * 16, r = row0 + fr;
    f32x4 a1[4] = {}, a2[4] = {};
    wave_gemm(OA, 1024, WoA, 512, row0, c0, 512, a1);
    wave_gemm(OB, 1024, WoB, 512, row0, c0, 512, a2);
    if (r >= NTOK) return;
#pragma unroll
    for (int n = 0; n < 4; ++n) {
        const u32x2 ga = *(const u32x2*)(GA + (size_t)r * 1024 + c0 + 16 * n + 4 * fq), gb = *(const u32x2*)(GB + (size_t)r * 1024 + c0 + 16 * n + 4 * fq);
        float v[4];
        v[0] = bf2f(ga.x & 0xffff) * a1[n][0] + bf2f(gb.x & 0xffff) * a2[n][0]; v[1] = bf2f(ga.x >> 16) * a1[n][1] + bf2f(gb.x >> 16) * a2[n][1];
        v[2] = bf2f(ga.y & 0xffff) * a1[n][2] + bf2f(gb.y & 0xffff) * a2[n][2]; v[3] = bf2f(ga.y >> 16) * a1[n][3] + bf2f(gb.y >> 16) * a2[n][3];
        u32x2 o; o.x = pk2(v[0], v[1]); o.y = pk2(v[2], v[3]);
        *(u32x2*)(MIX + (size_t)r * 1024 + c0 + 16 * n + 4 * fq) = o;
    }
}
__global__ void __launch_bounds__(256) k_out_naive(const bf16_t* MIX, const bf16_t* Wout, const float* rreal, const float* rmeta, int meta_bcast, float* oreal, float* ometa) {
    const int lane = threadIdx.x & 63, w = threadIdx.x >> 6, fr = lane & 15, fq = lane >> 4;
    const int c0 = blockIdx.x * 64, row0 = blockIdx.y * 64 + w * 16, r = row0 + fr;
    f32x4 acc[4] = {};
    wave_gemm(MIX, 1024, Wout, 1024, row0, c0, 1024, acc);
    if (r >= NTOK) return;
    const float* rs; float* od;
    if (r < NREAL) { rs = rreal + (size_t)r * DM; od = oreal + (size_t)r * DM; }
    else { rs = rmeta + (size_t)(meta_bcast ? ((r - NREAL) & 15) : (r - NREAL)) * DM; od = ometa ? ometa + (size_t)(r - NREAL) * DM : nullptr; }
    if (!od) return;
#pragma unroll
    for (int n = 0; n < 4; ++n) { const f32x4 rv = *(const f32x4*)(rs + c0 + 16 * n + 4 * fq); *(f32x4*)(od + c0 + 16 * n + 4 * fq) = rv + acc[n]; }
}

__global__ void __launch_bounds__(256) k_gqa_naive(const bf16_t* __restrict__ QA, const bf16_t* __restrict__ KA, const bf16_t* __restrict__ VA, bf16_t* ZA) {
    __shared__ __attribute__((aligned(16))) bf16_t Ks[64 * 64];
    __shared__ __attribute__((aligned(16))) bf16_t Vs[64 * 64];
    const int blk = blockIdx.x, h = blockIdx.y, b = blockIdx.z, t = threadIdx.x, kvh = h >> 2;
    int r; bool active = true;
    if (blk < 16) r = b * 4096 + blk * 256 + t; else { active = t < 16; r = NREAL + b * 16 + (active ? t : 0); }
    float q[64], o[64];
    {
        const bf16_t* qp = QA + (size_t)r * 512 + h * 64;
#pragma unroll
        for (int c = 0; c < 8; ++c) { const u32x4 v = *(const u32x4*)(qp + 8 * c);
            q[8 * c + 0] = bf2f(v.x & 0xffff); q[8 * c + 1] = bf2f(v.x >> 16); q[8 * c + 2] = bf2f(v.y & 0xffff); q[8 * c + 3] = bf2f(v.y >> 16);
            q[8 * c + 4] = bf2f(v.z & 0xffff); q[8 * c + 5] = bf2f(v.z >> 16); q[8 * c + 6] = bf2f(v.w & 0xffff); q[8 * c + 7] = bf2f(v.w >> 16); }
    }
#pragma unroll
    for (int d = 0; d < 64; ++d) o[d] = 0.f;
    float m = -INFINITY, l = 0.f;
    const bf16_t* Kb = KA + (size_t)(b * 2 + kvh) * KVROWS * 64; const bf16_t* Vb = VA + (size_t)(b * 2 + kvh) * KVROWS * 64;
    for (int tile = 0; tile < 65; ++tile) {
        __syncthreads();
#pragma unroll
        for (int i = 0; i < 2; ++i) { const int e = (t + 256 * i) * 8; *(u32x4*)(Ks + e) = *(const u32x4*)(Kb + (size_t)tile * 4096 + e); *(u32x4*)(Vs + e) = *(const u32x4*)(Vb + (size_t)tile * 4096 + e); }
        __syncthreads();
        const int nvalid = tile == 0 ? 16 : 64;
#pragma unroll 1
        for (int j = 0; j < nvalid; ++j) {
            float acc = 0.f;
#pragma unroll
            for (int c = 0; c < 8; ++c) { const u32x4 v = *(const u32x4*)(Ks + j * 64 + 8 * c);
                acc += q[8 * c + 0] * bf2f(v.x & 0xffff) + q[8 * c + 1] * bf2f(v.x >> 16) + q[8 * c + 2] * bf2f(v.y & 0xffff) + q[8 * c + 3] * bf2f(v.y >> 16)
                     + q[8 * c + 4] * bf2f(v.z & 0xffff) + q[8 * c + 5] * bf2f(v.z >> 16) + q[8 * c + 6] * bf2f(v.w & 0xffff) + q[8 * c + 7] * bf2f(v.w >> 16); }
            if (acc > m) { const float sc = exp2f(m - acc); m = acc; l *= sc;
#pragma unroll
                for (int d = 0; d < 64; ++d) o[d] *= sc; }
            const float p = exp2f(acc - m); l += p;
#pragma unroll
            for (int c = 0; c < 8; ++c) { const u32x4 v = *(const u32x4*)(Vs + j * 64 + 8 * c);
                o[8 * c + 0] += p * bf2f(v.x & 0xffff); o[8 * c + 1] += p * bf2f(v.x >> 16); o[8 * c + 2] += p * bf2f(v.y & 0xffff); o[8 * c + 3] += p * bf2f(v.y >> 16);
                o[8 * c + 4] += p * bf2f(v.z & 0xffff); o[8 * c + 5] += p * bf2f(v.z >> 16); o[8 * c + 6] += p * bf2f(v.w & 0xffff); o[8 * c + 7] += p * bf2f(v.w >> 16); }
        }
    }
    if (!active) return;
    const float inv = 1.f / l; bf16_t* zp = ZA + (size_t)r * 1024 + h * 64;
#pragma unroll
    for (int c = 0; c < 8; ++c) { const u32x4 z = *(const u32x4*)(zp + 8 * c); u32x4 w;
        w.x = pk2(o[8 * c + 0] * inv * bf2f(z.x & 0xffff), o[8 * c + 1] * inv * bf2f(z.x >> 16)); w.y = pk2(o[8 * c + 2] * inv * bf2f(z.y & 0xffff), o[8 * c + 3] * inv * bf2f(z.y >> 16));
        w.z = pk2(o[8 * c + 4] * inv * bf2f(z.z & 0xffff), o[8 * c + 5] * inv * bf2f(z.z >> 16)); w.w = pk2(o[8 * c + 6] * inv * bf2f(z.w & 0xffff), o[8 * c + 7] * inv * bf2f(z.w >> 16));
        *(u32x4*)(zp + 8 * c) = w; }
}

__global__ void __launch_bounds__(64) k_na_naive(const bf16_t* __restrict__ QB, const bf16_t* __restrict__ KB, const bf16_t* __restrict__ VB, bf16_t* ZB, const float* __restrict__ rpb) {
    const int gyb = blockIdx.x, h = blockIdx.y, b = blockIdx.z, t = threadIdx.x;
    int r, gy = 0, gx = 0; bool active = true, meta = gyb == 64;
    if (!meta) { gy = gyb; gx = t; r = b * 4096 + gy * 64 + gx; } else { active = t < 16; r = NREAL + b * 16 + (active ? t : 0); }
    const int rs = min(max(gy - 4, 0), 56), cs = min(max(gx - 8, 0), 48);
    float q[64], o[64];
    {
        const bf16_t* qp = QB + (size_t)r * 512 + h * 64;
#pragma unroll
        for (int c = 0; c < 8; ++c) { const u32x4 v = *(const u32x4*)(qp + 8 * c);
            q[8 * c + 0] = bf2f(v.x & 0xffff); q[8 * c + 1] = bf2f(v.x >> 16); q[8 * c + 2] = bf2f(v.y & 0xffff); q[8 * c + 3] = bf2f(v.y >> 16);
            q[8 * c + 4] = bf2f(v.z & 0xffff); q[8 * c + 5] = bf2f(v.z >> 16); q[8 * c + 6] = bf2f(v.w & 0xffff); q[8 * c + 7] = bf2f(v.w >> 16); }
    }
#pragma unroll
    for (int d = 0; d < 64; ++d) o[d] = 0.f;
    float m = -INFINITY, l = 0.f;
    const bf16_t* Kb = KB + (size_t)(b * 8 + h) * KVROWS * 64; const bf16_t* Vb = VB + (size_t)(b * 8 + h) * KVROWS * 64;
    const float* rp = rpb + h * 15 * 31;
#pragma unroll 1
    for (int ch = meta ? 8 : 0; ch < 9; ++ch) {
        const int kr = rs + ch; const size_t rowbase = (ch < 8) ? (size_t)(64 + kr * 64 + cs) : 0;
#pragma unroll 1
        for (int jj = 0; jj < 16; ++jj) {
            const bf16_t* kp = Kb + (rowbase + jj) * 64; float acc = 0.f;
#pragma unroll
            for (int c = 0; c < 8; ++c) { const u32x4 v = *(const u32x4*)(kp + 8 * c);
                acc += q[8 * c + 0] * bf2f(v.x & 0xffff) + q[8 * c + 1] * bf2f(v.x >> 16) + q[8 * c + 2] * bf2f(v.y & 0xffff) + q[8 * c + 3] * bf2f(v.y >> 16)
                     + q[8 * c + 4] * bf2f(v.z & 0xffff) + q[8 * c + 5] * bf2f(v.z >> 16) + q[8 * c + 6] * bf2f(v.w & 0xffff) + q[8 * c + 7] * bf2f(v.w >> 16); }
            if (ch < 8) acc += rp[(kr - gy + 7) * 31 + (cs + jj - gx + 15)] * LOG2E;
            if (acc > m) { const float sc = exp2f(m - acc); m = acc; l *= sc;
#pragma unroll
                for (int d = 0; d < 64; ++d) o[d] *= sc; }
            const float p = exp2f(acc - m); l += p; const bf16_t* vp = Vb + (rowbase + jj) * 64;
#pragma unroll
            for (int c = 0; c < 8; ++c) { const u32x4 v = *(const u32x4*)(vp + 8 * c);
                o[8 * c + 0] += p * bf2f(v.x & 0xffff); o[8 * c + 1] += p * bf2f(v.x >> 16); o[8 * c + 2] += p * bf2f(v.y & 0xffff); o[8 * c + 3] += p * bf2f(v.y >> 16);
                o[8 * c + 4] += p * bf2f(v.z & 0xffff); o[8 * c + 5] += p * bf2f(v.z >> 16); o[8 * c + 6] += p * bf2f(v.w & 0xffff); o[8 * c + 7] += p * bf2f(v.w >> 16); }
        }
    }
    if (!active) return;
    const float inv = 1.f / l; bf16_t* zp = ZB + (size_t)r * 1024 + h * 64;
#pragma unroll
    for (int c = 0; c < 8; ++c) { const u32x4 z = *(const u32x4*)(zp + 8 * c); u32x4 w;
        w.x = pk2(o[8 * c + 0] * inv * bf2f(z.x & 0xffff), o[8 * c + 1] * inv * bf2f(z.x >> 16)); w.y = pk2(o[8 * c + 2] * inv * bf2f(z.y & 0xffff), o[8 * c + 3] * inv * bf2f(z.y >> 16));
        w.z = pk2(o[8 * c + 4] * inv * bf2f(z.z & 0xffff), o[8 * c + 5] * inv * bf2f(z.z >> 16)); w.w = pk2(o[8 * c + 6] * inv * bf2f(z.w & 0xffff), o[8 * c + 7] * inv * bf2f(z.w >> 16));
        *(u32x4*)(zp + 8 * c) = w; }
}

namespace pg8 {
#define PG8_LAS __attribute__((address_space(3)))
typedef unsigned short bf16_t;
typedef short bf16x8 __attribute__((ext_vector_type(8)));
typedef float f32x4 __attribute__((ext_vector_type(4)));
typedef unsigned u32x4 __attribute__((ext_vector_type(4)));
constexpr int BM = 256, BK = 64, HALF = 128, HTB = HALF * BK * 2  , STAGE_BYTES = 8 * HTB, NXCD = 8, WGM = 8;

__host__ __device__ __forceinline__ int lds_byte(int r, int c) { const int st = (r >> 4) * 2 + (c >> 5), rr = r & 15, cc = c & 31, ob = rr * 64 + cc * 2; return st * 1024 + (ob ^ (((ob >> 9) & 1) << 5)); }
__host__ __device__ __forceinline__ void stage_rc(int b, int& R, int& C) { const int st = b / 1024, sb = b % 1024, swz = sb ^ (((sb >> 9) & 1) << 5); R = (st >> 1) * 16 + swz / 64; C = (st & 1) * 32 + (swz % 64) / 2; }
__host__ __device__ __forceinline__ int perm32(int rho) { const int n = rho >> 4, i = rho & 15; return 8 * (i >> 2) + 4 * n + (i & 3); }

struct Unit { int pm, pn; };
struct Gemm { const bf16_t* A; const bf16_t* Bt; int M, N, K; };

struct StaticOrder {
    int nM, nN, nwg, G, c;
    __host__ __device__ void init(int M, int N, int G_, int c_) { nM = M / BM; nN = N / BM; nwg = nM * nN; G = G_; c = c_; }
    __host__ __device__ bool next(int i, Unit& u) const {
        const long L = (long)i * G + c; if (L >= nwg) return false;
        int wgid = (int)L; { const int q = nwg / NXCD, r = nwg % NXCD, xcd = wgid % NXCD, off = wgid / NXCD; wgid = (xcd < r ? xcd * (q + 1) : r * (q + 1) + (xcd - r) * q) + off; }
        const int nig = WGM * nN, gid = wgid / nig, fm = gid * WGM, gsz = (nM - fm) < WGM ? (nM - fm) : WGM;
        u.pm = fm + ((wgid % nig) % gsz); u.pn = (wgid % nig) / gsz; return true;
    }
    __device__ __forceinline__ void a_ready(const Unit&) const {}
    __device__ __forceinline__ void done(const Unit&) const {}
};
__device__ __forceinline__ unsigned cvt_pk_bf16(float lo, float hi) { unsigned r; asm volatile("v_cvt_pk_bf16_f32 %0, %1, %2" : "=v"(r) : "v"(lo), "v"(hi)); return r; }

__device__ __forceinline__ float rowp_rstd(const float* rowp, int r) {
    const f32x4* p = (const f32x4*)(rowp + (size_t)r * 16); const f32x4 a = p[0], b = p[1], c = p[2], d = p[3];
    const float ss = ((a[0] + a[1]) + (a[2] + a[3])) + ((b[0] + b[1]) + (b[2] + b[3])) + ((c[0] + c[1]) + (c[2] + c[3])) + ((d[0] + d[1]) + (d[2] + d[3]));
    return rsqrtf(ss * (1.f / DM) + EPS);
}
struct EpiIn {
    static constexpr bool PERM = false, AFTER_DRAIN = false, MID = false;
    const float* rowp; const float* qg; const float* kg; const float* rope;
    bf16_t *QA, *KA, *VA, *Z, *QB, *KB, *VB, *GA, *GB;
    template <bool NR> __device__ __forceinline__ void head_rows(const f32x4 (&acc)[2][2][4][2], int rbase, int fq, const float* g, float scale, bool kv, bf16_t* dst, int nh, int head) const {
        const int fq1 = fq >> 1, fq0 = fq & 1, dl = 32 * fq1 + 8 * fq0;
        f32x4 gv[2][2];
        if (NR) {
#pragma unroll
            for (int bj = 0; bj < 2; ++bj)
#pragma unroll
                for (int n = 0; n < 2; ++n) gv[bj][n] = *(const f32x4*)(g + dl + 16 * bj + 4 * n);
        }
#pragma unroll
        for (int ai = 0; ai < 2; ++ai)
#pragma unroll
            for (int m = 0; m < 4; ++m) {
                const int r = rbase + ai * HALF + m * 16; const RowInfo ri = row_info(r);
                const float rstd = rowp_rstd(rowp, r);
                f32x4 x[2][2];
#pragma unroll
                for (int bj = 0; bj < 2; ++bj)
#pragma unroll
                    for (int n = 0; n < 2; ++n) x[bj][n] = acc[ai][bj][m][n] * rstd;
                if (NR) {
                    float ss = 0.f;
#pragma unroll
                    for (int bj = 0; bj < 2; ++bj)
#pragma unroll
                        for (int n = 0; n < 2; ++n) { const f32x4 t = x[bj][n]; ss += (t[0] * t[0] + t[1] * t[1]) + (t[2] * t[2] + t[3] * t[3]); }
                    ss += __shfl_xor(ss, 16); ss += __shfl_xor(ss, 32);
                    const float rn = rsqrtf(ss * (1.f / 64.f) + EPS);
                    const int pos = fq1 ? ri.gx : ri.gy;
#pragma unroll
                    for (int n = 0; n < 2; ++n) {
                        const f32x4 c = *(const f32x4*)(rope + pos * 16 + 8 * fq0 + 4 * n), sn = *(const f32x4*)(rope + 1024 + pos * 16 + 8 * fq0 + 4 * n);
                        const f32x4 a0 = x[0][n] * rn * gv[0][n], a1 = x[1][n] * rn * gv[1][n];
                        x[0][n] = a0 * c - a1 * sn; x[1][n] = a1 * c + a0 * sn;
                    }
                }
                if (ri.valid) {
                    bf16_t* rowp_ = kv ? dst + ((size_t)(ri.b * nh + head) * KVROWS + ri.lp) * 64 : dst + (size_t)r * 512 + head * 64;
#pragma unroll
                    for (int bj = 0; bj < 2; ++bj) { const f32x4 v0 = x[bj][0] * scale, v1 = x[bj][1] * scale; u32x4 w; w.x = cvt_pk_bf16(v0[0], v0[1]); w.y = cvt_pk_bf16(v0[2], v0[3]); w.z = cvt_pk_bf16(v1[0], v1[1]); w.w = cvt_pk_bf16(v1[2], v1[3]);
                        *(u32x4*)(rowp_ + dl + 16 * bj) = w; }
                }
                asm volatile("" ::: "memory");
            }
    }
    template <int ACT> __device__ __forceinline__ void elem_rows(const f32x4 (&acc)[2][2][4][2], int rbase, int wc, int fq, bf16_t* dst, int colbase) const {
#pragma unroll
        for (int ai = 0; ai < 2; ++ai)
#pragma unroll
            for (int m = 0; m < 4; ++m) {
                const int r = rbase + ai * HALF + m * 16; const float rstd = rowp_rstd(rowp, r);
                if (r < NTOK) {
#pragma unroll
                    for (int bj = 0; bj < 2; ++bj) { float v[8];
#pragma unroll
                        for (int n = 0; n < 2; ++n)
#pragma unroll
                            for (int j = 0; j < 4; ++j) { const float t = acc[ai][bj][m][n][j] * rstd; const float sg = __builtin_amdgcn_rcpf(1.f + __builtin_amdgcn_exp2f(-LOG2E * t)); v[4 * n + j] = ACT == 1 ? t * sg : sg; }
                        u32x4 w; w.x = cvt_pk_bf16(v[0], v[1]); w.y = cvt_pk_bf16(v[2], v[3]); w.z = cvt_pk_bf16(v[4], v[5]); w.w = cvt_pk_bf16(v[6], v[7]);
                        *(u32x4*)(dst + (size_t)r * 1024 + colbase + 128 * bj + 32 * wc + 8 * fq) = w; }
                }
                asm volatile("" ::: "memory");
            }
    }
    __device__ __forceinline__ void operator()(const f32x4 (&acc)[2][2][4][2], const Unit& u, int wr, int wc, int fr, int fq) const {
        asm volatile("" : "+v"(fr), "+v"(fq));
        const int rbase = u.pm * BM + wr * 64 + fr, t = u.pn;
        if (t < 2) head_rows<true>(acc, rbase, fq, qg, C2, false, QA, 0, 4 * t + wc);
        else if (t == 2) { if (wc < 2) head_rows<true>(acc, rbase, fq, kg, 1.f, true, KA, 2, wc); else head_rows<false>(acc, rbase, fq, nullptr, 1.f, true, VA, 2, wc - 2); }
        else if (t < 5) elem_rows<1>(acc, rbase, wc, fq, Z, (t - 3) * 256);
        else if (t < 7) head_rows<false>(acc, rbase, fq, nullptr, C2, false, QB, 0, 4 * (t - 5) + wc);
        else if (t < 9) head_rows<false>(acc, rbase, fq, nullptr, 1.f, true, KB, 8, 4 * (t - 7) + wc);
        else if (t < 11) head_rows<false>(acc, rbase, fq, nullptr, 1.f, true, VB, 8, 4 * (t - 9) + wc);
        else if (t < 13) elem_rows<1>(acc, rbase, wc, fq, Z, 512 + (t - 11) * 256);
        else if (t < 17) elem_rows<2>(acc, rbase, wc, fq, GA, (t - 13) * 256);
        else elem_rows<2>(acc, rbase, wc, fq, GB, (t - 17) * 256);
    }
};
struct EpiMix {
    static constexpr bool PERM = false, AFTER_DRAIN = false, MID = true;
    const bf16_t* GA; const bf16_t* GB; bf16_t* MIX;
    __device__ __forceinline__ void mid(f32x4 (&acc)[2][2][4][2], const Unit& u, int wr, int wc, int fr, int fq) const {
        asm volatile("" : "+v"(fr), "+v"(fq));
        const int rbase = u.pm * BM + wr * 64 + fr, cb = u.pn * BM + 32 * wc + 8 * fq;
#pragma unroll
        for (int ai = 0; ai < 2; ++ai)
#pragma unroll
            for (int m = 0; m < 4; ++m) { const size_t off = (size_t)(rbase + ai * HALF + m * 16) * 1024 + cb;
#pragma unroll
                for (int bj = 0; bj < 2; ++bj) { const u32x4 a = *(const u32x4*)(GA + off + 128 * bj), b = *(const u32x4*)(GB + off + 128 * bj);
#pragma unroll
                    for (int q = 0; q < 4; ++q) { const float a0 = bf2f(a[q] & 0xffff), a1 = bf2f(a[q] >> 16), b0 = fmaxf(bf2f(b[q] & 0xffff), 1e-30f), b1 = fmaxf(bf2f(b[q] >> 16), 1e-30f);
                        acc[ai][bj][m][q >> 1][2 * (q & 1)] *= a0 * __builtin_amdgcn_rcpf(b0); acc[ai][bj][m][q >> 1][2 * (q & 1) + 1] *= a1 * __builtin_amdgcn_rcpf(b1); } }
                asm volatile("" ::: "memory"); }
    }
    __device__ __forceinline__ void operator()(const f32x4 (&acc)[2][2][4][2], const Unit& u, int wr, int wc, int fr, int fq) const {
        asm volatile("" : "+v"(fr), "+v"(fq));
        const int rbase = u.pm * BM + wr * 64 + fr, cb = u.pn * BM + 32 * wc + 8 * fq;
#pragma unroll
        for (int ai = 0; ai < 2; ++ai)
#pragma unroll
            for (int m = 0; m < 4; ++m) { const int r = rbase + ai * HALF + m * 16; const size_t off = (size_t)r * 1024 + cb;
                if (r < NTOK) {
#pragma unroll
                    for (int bj = 0; bj < 2; ++bj) { const u32x4 b = *(const u32x4*)(GB + off + 128 * bj); u32x4 w;
#pragma unroll
                        for (int q = 0; q < 4; ++q) { const float b0 = fmaxf(bf2f(b[q] & 0xffff), 1e-30f), b1 = fmaxf(bf2f(b[q] >> 16), 1e-30f);
                            w[q] = cvt_pk_bf16(acc[ai][bj][m][q >> 1][2 * (q & 1)] * b0, acc[ai][bj][m][q >> 1][2 * (q & 1) + 1] * b1); }
                        *(u32x4*)(MIX + off + 128 * bj) = w; } }
                asm volatile("" ::: "memory"); }
    }
};
struct EpiOut {
    static constexpr bool PERM = false, AFTER_DRAIN = false, MID = false;
    const float* rreal; const float* rmeta; int meta_bcast; float* oreal; float* ometa; const float* gnext; bf16_t* XN; float* rowp;
    __device__ __forceinline__ void operator()(const f32x4 (&acc)[2][2][4][2], const Unit& u, int wr, int wc, int fr, int fq) const {
        asm volatile("" : "+v"(fr), "+v"(fq));
        const int rbase = u.pm * BM + wr * 64 + fr, cb = u.pn * BM + 32 * wc + 8 * fq;
        f32x4 gv[2][2];
        if (XN) {
#pragma unroll
            for (int bj = 0; bj < 2; ++bj)
#pragma unroll
                for (int n = 0; n < 2; ++n) gv[bj][n] = *(const f32x4*)(gnext + cb + 128 * bj + 4 * n);
        }
#pragma unroll
        for (int ai = 0; ai < 2; ++ai)
#pragma unroll
            for (int m = 0; m < 4; ++m) { const int r = rbase + ai * HALF + m * 16;
                const float* rs; float* od;
                if (r < NREAL) { rs = rreal + (size_t)r * DM; od = oreal + (size_t)r * DM; }
                else { const int q = (r < NTOK) ? r - NREAL : 0; rs = rmeta + (size_t)(meta_bcast ? (q & 15) : q) * DM; od = (ometa && r < NTOK) ? ometa + (size_t)q * DM : nullptr; }
                float ss = 0.f;
#pragma unroll
                for (int bj = 0; bj < 2; ++bj) { f32x4 h0 = *(const f32x4*)(rs + cb + 128 * bj) + acc[ai][bj][m][0], h1 = *(const f32x4*)(rs + cb + 128 * bj + 4) + acc[ai][bj][m][1];
                    ss += ((h0[0] * h0[0] + h0[1] * h0[1]) + (h0[2] * h0[2] + h0[3] * h0[3])) + ((h1[0] * h1[0] + h1[1] * h1[1]) + (h1[2] * h1[2] + h1[3] * h1[3]));
                    if (od) { *(f32x4*)(od + cb + 128 * bj) = h0; *(f32x4*)(od + cb + 128 * bj + 4) = h1; }
                    if (XN && r < NTOK) { h0 = h0 * gv[bj][0]; h1 = h1 * gv[bj][1]; u32x4 w; w.x = cvt_pk_bf16(h0[0], h0[1]); w.y = cvt_pk_bf16(h0[2], h0[3]); w.z = cvt_pk_bf16(h1[0], h1[1]); w.w = cvt_pk_bf16(h1[2], h1[3]);
                        *(u32x4*)(XN + (size_t)r * DM + cb + 128 * bj) = w; } }
                ss += __shfl_xor(ss, 16); ss += __shfl_xor(ss, 32);
                if (fq == 0 && r < NTOK) rowp[(size_t)r * 16 + 4 * u.pn + wc] = ss;
                asm volatile("" ::: "memory"); }
    }
};
template <class Epi, class Sched, bool ALIGN_EPI = false, bool SP2 = false>
__device__ __forceinline__ void gemm_phase(PG8_LAS unsigned char* lds, const Gemm g, const Sched& S, const Epi& E) {
    int tid_ = threadIdx.x; asm volatile("" : "+v"(tid_));
    const int tid = tid_, wid = __builtin_amdgcn_readfirstlane(tid >> 6), lane = tid & 63, wr = wid >> 2, wc = wid & 3, fr = lane & 15, fq = lane >> 4;
    const int K = g.K, nt = K / BK;
    unsigned voffA[2], voffB[2];
#pragma unroll
    for (int i = 0; i < 2; ++i) { int R, C; stage_rc(tid * 16 + i * 8192, R, C); const int Rb = Epi::PERM ? ((R & ~31) + perm32(R & 31)) : R;
        voffA[i] = (unsigned)(R * K + C) * 2u; voffB[i] = (unsigned)(Rb * K + C) * 2u; }
    const size_t kstep = (size_t)(BK * 2);
    const size_t hstep = (size_t)HALF * K * 2;
    const size_t tstep = 2 * hstep;
    const unsigned ldsw = (unsigned)wid * 1024u;
    const int aoff = lds_byte(wr * 64 + fr, fq * 8), boff = lds_byte(wc * 32 + fr, fq * 8);
#define PG8_SA(b, h) (((b) * 2 + (h)) * HTB)
#define PG8_SB(b, h) ((4 + (b) * 2 + (h)) * HTB)
#define PG8_STAGE(bufoff, gbase, voff) do { _Pragma("unroll") for (int _i = 0; _i < 2; ++_i) \
        __builtin_amdgcn_global_load_lds((const unsigned*)((const char*)(gbase) + (voff)[_i]), (PG8_LAS unsigned*)(lds + (bufoff) + ldsw + _i * 8192), 16, 0, 0); } while (0)
#define PG8_LDA(dst, b, h) do { _Pragma("unroll") for (int m = 0; m < 4; ++m) _Pragma("unroll") for (int k = 0; k < 2; ++k) dst[m][k] = *(const PG8_LAS bf16x8*)(lds + PG8_SA(b, h) + aoff + m * 2048 + k * 1024); } while (0)
#define PG8_LDB(dst, b, h) do { _Pragma("unroll") for (int n = 0; n < 2; ++n) _Pragma("unroll") for (int k = 0; k < 2; ++k) dst[n][k] = *(const PG8_LAS bf16x8*)(lds + PG8_SB(b, h) + boff + n * 2048 + k * 1024); } while (0)
#define PG8_MMA(ai, bj, At, Bt) do { __builtin_amdgcn_s_setprio(1); _Pragma("unroll") for (int m = 0; m < 4; ++m) _Pragma("unroll") for (int n = 0; n < 2; ++n) _Pragma("unroll") for (int k = 0; k < 2; ++k) \
        acc[ai][bj][m][n] = __builtin_amdgcn_mfma_f32_16x16x32_bf16(Bt[n][k], At[m][k], acc[ai][bj][m][n], 0, 0, 0); __builtin_amdgcn_s_setprio(0); } while (0)
#define PG8_WAIT_V(n) asm volatile("s_waitcnt vmcnt(" #n ")" ::: "memory")
#define PG8_WAIT_L(n) asm volatile("s_waitcnt lgkmcnt(" #n ")" ::: "memory")
#define PG8_BAR __builtin_amdgcn_s_barrier()
#define PG8_SCHED __builtin_amdgcn_sched_barrier(0)
    Unit cur, nxt; int ui = 0;
    (void)S.next(0, cur);
    f32x4 acc[2][2][4][2];
#pragma unroll
    for (int a = 0; a < 2; ++a)
#pragma unroll
        for (int b = 0; b < 2; ++b)
#pragma unroll
            for (int m = 0; m < 4; ++m)
#pragma unroll
                for (int n = 0; n < 2; ++n) acc[a][b][m][n] = (f32x4){0.f, 0.f, 0.f, 0.f};
    bf16x8 At[4][2], B0[2][2], B1[2][2];
    const char* cA = (const char*)g.A + (size_t)cur.pm * tstep; const char* cB = (const char*)g.Bt + (size_t)cur.pn * tstep;
    S.a_ready(cur);
    if constexpr (SP2) {
        PG8_STAGE(PG8_SB(0, 0), cB, voffB); PG8_STAGE(PG8_SB(0, 1), cB + hstep, voffB); PG8_STAGE(PG8_SA(0, 0), cA, voffA); PG8_STAGE(PG8_SA(0, 1), cA + hstep, voffA);
        if (wr == 1) PG8_BAR;
        PG8_WAIT_V(2); PG8_BAR;
        PG8_STAGE(PG8_SB(1, 0), cB + kstep, voffB); PG8_STAGE(PG8_SA(1, 0), cA + kstep, voffA); PG8_STAGE(PG8_SB(1, 1), cB + hstep + kstep, voffB);
        PG8_WAIT_V(6); PG8_BAR;
    } else {
        PG8_STAGE(PG8_SB(0, 0), cB, voffB); PG8_STAGE(PG8_SA(0, 0), cA, voffA); PG8_STAGE(PG8_SB(0, 1), cB + hstep, voffB); PG8_STAGE(PG8_SA(0, 1), cA + hstep, voffA);
        if (wr == 1) PG8_BAR;
        PG8_WAIT_V(4); PG8_BAR;
        PG8_STAGE(PG8_SB(1, 0), cB + kstep, voffB); PG8_STAGE(PG8_SA(1, 0), cA + kstep, voffA); PG8_STAGE(PG8_SB(1, 1), cB + hstep + kstep, voffB);
        PG8_WAIT_V(6); PG8_BAR;
    }
    for (;;) {
        const bool has_next = S.next(ui + 1, nxt);
        const char* nA = has_next ? (const char*)g.A + (size_t)nxt.pm * tstep : cA; const char* nB = has_next ? (const char*)g.Bt + (size_t)nxt.pn * tstep : cB;
        for (int t = 0; t < nt; t += 2) {
            const bool last = (t == nt - 2);
            const char* a1 = cA + (size_t)(t + 1) * kstep;
            const char* a2 = last ? nA : cA + (size_t)(t + 2) * kstep; const char* b2 = last ? nB : cB + (size_t)(t + 2) * kstep;
            const char* a3 = a2 + kstep; const char* b3 = b2 + kstep;
            if (last && has_next) S.a_ready(nxt);
            if constexpr (Epi::MID) { if (t == nt / 2) E.mid(acc, cur, wr, wc, fr, fq); }
            if constexpr (SP2) {
            PG8_LDB(B0, 0, 0); PG8_LDB(B1, 0, 1); PG8_SCHED; PG8_LDA(At, 0, 0); PG8_STAGE(PG8_SA(1, 1), a1 + hstep, voffA);
            PG8_WAIT_V(8); PG8_WAIT_L(0); PG8_BAR; PG8_MMA(0, 0, At, B0); PG8_MMA(0, 1, At, B1); PG8_BAR; PG8_SCHED;
            PG8_LDA(At, 0, 1); PG8_STAGE(PG8_SB(0, 0), b2, voffB); PG8_STAGE(PG8_SB(0, 1), b2 + hstep, voffB); PG8_STAGE(PG8_SA(0, 0), a2, voffA);
            PG8_WAIT_V(8); PG8_WAIT_L(0); PG8_BAR; PG8_MMA(1, 0, At, B0); PG8_MMA(1, 1, At, B1); PG8_BAR; PG8_SCHED;
            PG8_LDB(B0, 1, 0); PG8_LDB(B1, 1, 1); PG8_SCHED; PG8_LDA(At, 1, 0); PG8_STAGE(PG8_SA(0, 1), a2 + hstep, voffA);
            PG8_WAIT_V(8); PG8_WAIT_L(0); PG8_BAR; PG8_MMA(0, 0, At, B0); PG8_MMA(0, 1, At, B1); PG8_BAR; PG8_SCHED;
            PG8_LDA(At, 1, 1); PG8_STAGE(PG8_SB(1, 0), b3, voffB); PG8_STAGE(PG8_SB(1, 1), b3 + hstep, voffB); PG8_STAGE(PG8_SA(1, 0), a3, voffA);
            PG8_WAIT_V(8); PG8_WAIT_L(0); PG8_BAR; PG8_MMA(1, 0, At, B0); PG8_MMA(1, 1, At, B1); PG8_BAR; PG8_SCHED;
            } else {
            PG8_LDB(B0, 0, 0); PG8_SCHED; PG8_LDA(At, 0, 0); PG8_STAGE(PG8_SA(1, 1), a1 + hstep, voffA);
            PG8_WAIT_L(8); PG8_BAR; PG8_WAIT_L(0); PG8_MMA(0, 0, At, B0); PG8_BAR; PG8_SCHED;
            PG8_LDB(B1, 0, 1); PG8_STAGE(PG8_SB(0, 0), b2, voffB);
            PG8_BAR; PG8_WAIT_L(0); PG8_MMA(0, 1, At, B1); PG8_BAR;
            PG8_LDA(At, 0, 1); PG8_STAGE(PG8_SA(0, 0), a2, voffA);
            PG8_BAR; PG8_WAIT_L(0); PG8_MMA(1, 0, At, B0); PG8_BAR; PG8_SCHED;
            PG8_STAGE(PG8_SB(0, 1), b2 + hstep, voffB);
            PG8_WAIT_V(6); PG8_BAR; PG8_MMA(1, 1, At, B1); PG8_BAR;
            PG8_LDB(B0, 1, 0); PG8_SCHED; PG8_LDA(At, 1, 0); PG8_STAGE(PG8_SA(0, 1), a2 + hstep, voffA);
            PG8_WAIT_L(8); PG8_BAR; PG8_WAIT_L(0); PG8_MMA(0, 0, At, B0); PG8_BAR; PG8_SCHED;
            PG8_LDB(B1, 1, 1); PG8_STAGE(PG8_SB(1, 0), b3, voffB);
            PG8_BAR; PG8_WAIT_L(0); PG8_MMA(0, 1, At, B1); PG8_BAR;
            PG8_LDA(At, 1, 1); PG8_STAGE(PG8_SA(1, 0), a3, voffA);
            PG8_BAR; PG8_WAIT_L(0); PG8_MMA(1, 0, At, B0); PG8_BAR; PG8_SCHED;
            PG8_STAGE(PG8_SB(1, 1), b3 + hstep, voffB);
            PG8_WAIT_V(6); PG8_BAR; PG8_MMA(1, 1, At, B1); PG8_BAR;
            }
        }
        if constexpr (ALIGN_EPI) { if (wr == 0) PG8_BAR; }
        if constexpr (!Epi::AFTER_DRAIN) { E(acc, cur, wr, wc, fr, fq); S.done(cur); }
        if (!has_next) break;
#pragma unroll
        for (int a = 0; a < 2; ++a)
#pragma unroll
            for (int b = 0; b < 2; ++b)
#pragma unroll
                for (int m = 0; m < 4; ++m)
#pragma unroll
                    for (int n = 0; n < 2; ++n) acc[a][b][m][n] = (f32x4){0.f, 0.f, 0.f, 0.f};
        cur = nxt; cA = nA; cB = nB; ++ui;
        if constexpr (ALIGN_EPI) { if (wr == 1) PG8_BAR; }
    }
    PG8_WAIT_V(0);
    if constexpr (!ALIGN_EPI) { if (wr == 0) PG8_BAR; }
    PG8_BAR;
    if constexpr (Epi::AFTER_DRAIN) { E.fused(acc, cur, wr, wc, fr, fq, lds, wid, lane); S.done(cur); }
#undef PG8_SA
#undef PG8_SB
#undef PG8_STAGE
#undef PG8_LDA
#undef PG8_LDB
#undef PG8_MMA
#undef PG8_WAIT_V
#undef PG8_WAIT_L
#undef PG8_BAR
#undef PG8_SCHED
}
}

#include <hip/hip_bf16.h>
namespace attn_body {
using bf16=__hip_bfloat16;
using bf16x8=__attribute__((ext_vector_type(8)))short;
using s16x4=__attribute__((ext_vector_type(4)))short;
using f32x16=__attribute__((ext_vector_type(16)))float;
using u32x4=__attribute__((ext_vector_type(4)))unsigned;
constexpr int D=64,KVP=64;
constexpr int NW=8,QBLK=32,QB=QBLK*NW,KVBLK=64;
__device__ __forceinline__ int crow(int r,int hi){return (r&3)+8*(r>>2)+4*hi;}
#define SBAR() __builtin_amdgcn_sched_barrier(0)
__device__ __forceinline__ void mask_meta(f32x16&p0,f32x16&p1){
  const float NEG=-INFINITY;
  #pragma unroll
  for(int r=8;r<16;++r)p0[r]=NEG;
  #pragma unroll
  for(int r=0;r<16;++r)p1[r]=NEG;
}
__device__ __forceinline__ void na_mask(f32x16&p0,f32x16&p1,bool tvalid,int cb,const __attribute__((address_space(3))) float*bl){
  const float NEG=-INFINITY;
  if(!tvalid){
    #pragma unroll
    for(int r=0;r<16;++r){p0[r]=NEG;p1[r]=NEG;}
  }else{
    #pragma unroll
    for(int r=0;r<16;++r){const int k0=(r&3)+8*(r>>2); const float b0=bl[k0],b1=bl[k0+32];
      p0[r]=((unsigned)(k0+cb)<16u)?p0[r]+b0:NEG; p1[r]=((unsigned)(k0+32+cb)<16u)?p1[r]+b1:NEG;}
  }
}

constexpr int NSLOT=3, SLOTB=8192;
constexpr int LDS_K=0, LDS_V=NSLOT*SLOTB, LDS_WS=2*NSLOT*SLOTB, LDS_OST=LDS_WS+NW*64*4, LDS_TAB=LDS_OST+NW*4096, LDS_BYTES=LDS_TAB+2560;
constexpr float C2=0.125f*1.4426950408889634f;
__device__ __forceinline__ void glds16(const void*gsrc,unsigned lds_dst){unsigned keep;
  asm volatile("s_mov_b32 %0, m0\n\ts_mov_b32 m0, %2\n\ts_nop 0\n\tglobal_load_lds_dwordx4 %1, off\n\ts_mov_b32 m0, %0":"=&s"(keep):"v"(gsrc),"s"(lds_dst):"memory");}
__device__ __forceinline__ float max3f(float a,float b,float c){float r;asm("v_max3_f32 %0, %1, %2, %3":"=v"(r):"v"(a),"v"(b),"v"(c));return r;}
__device__ __forceinline__ float max2f(float a,float b){float r;asm("v_max_f32_e32 %0, %1, %2":"=v"(r):"v"(a),"v"(b));return r;}
__device__ __forceinline__ float fadd_s(float a,float b){float r;asm("v_add_f32_e32 %0, %1, %2":"=v"(r):"v"(a),"v"(b));return r;}
__device__ __forceinline__ float fsub_s(float a,float b){float r;asm("v_sub_f32_e32 %0, %1, %2":"=v"(r):"v"(a),"v"(b));return r;}
typedef float f32x2_t __attribute__((ext_vector_type(2))); typedef __bf16 bf16x2_t __attribute__((ext_vector_type(2)));
__device__ __forceinline__ unsigned cvtpk_s(float lo,float hi){f32x2_t v={lo,hi};bf16x2_t b=__builtin_convertvector(v,bf16x2_t);return __builtin_bit_cast(unsigned,b);}
#define WAIT_BAR(N) asm volatile("s_waitcnt vmcnt(" #N ") lgkmcnt(0)\n\ts_barrier":::"memory")

__device__ __forceinline__ void qkt(f32x16&p0,f32x16&p1,const char*Kslot,const bf16x8*qr,const f32x16&negm,int r32,int hi){
  const char*kb=Kslot+hi*1024+r32*16;
  #pragma unroll
  for(int d0=0;d0<4;++d0){
    const bf16x8 b0=*reinterpret_cast<const bf16x8*>(kb+d0*2048);
    const bf16x8 b1=*reinterpret_cast<const bf16x8*>(kb+d0*2048+512);
    if(d0==0){p0=__builtin_amdgcn_mfma_f32_32x32x16_bf16(b0,qr[0],negm,0,0,0);p1=__builtin_amdgcn_mfma_f32_32x32x16_bf16(b1,qr[0],negm,0,0,0);}
    else{p0=__builtin_amdgcn_mfma_f32_32x32x16_bf16(b0,qr[d0],p0,0,0,0);p1=__builtin_amdgcn_mfma_f32_32x32x16_bf16(b1,qr[d0],p1,0,0,0);}}
}
typedef __attribute__((address_space(3))) const char* lds_cptr;
typedef short v4i16_t __attribute__((ext_vector_type(4)));
__device__ __forceinline__ void kload8(bf16x8*kf,lds_cptr kp){
  kf[0]=*(const __attribute__((address_space(3))) bf16x8*)(kp);      kf[1]=*(const __attribute__((address_space(3))) bf16x8*)(kp+512);
  kf[2]=*(const __attribute__((address_space(3))) bf16x8*)(kp+2048); kf[3]=*(const __attribute__((address_space(3))) bf16x8*)(kp+2560);
  kf[4]=*(const __attribute__((address_space(3))) bf16x8*)(kp+4096); kf[5]=*(const __attribute__((address_space(3))) bf16x8*)(kp+4608);
  kf[6]=*(const __attribute__((address_space(3))) bf16x8*)(kp+6144); kf[7]=*(const __attribute__((address_space(3))) bf16x8*)(kp+6656);
}
__device__ __forceinline__ void kload2(bf16x8*kf,lds_cptr kp,int j){ kf[2*j]=*(const __attribute__((address_space(3))) bf16x8*)(kp+j*2048); kf[2*j+1]=*(const __attribute__((address_space(3))) bf16x8*)(kp+j*2048+512); }
__device__ __forceinline__ s16x4 vtr(lds_cptr p){ return __builtin_bit_cast(s16x4,__builtin_amdgcn_ds_read_tr16_b64_v4i16((__attribute__((address_space(3))) v4i16_t*)p)); }
__device__ __forceinline__ float rowmax(const f32x16&p0,const f32x16&p1){
  float a=max3f(p0[0],p0[1],p1[0]),b=max3f(p0[2],p0[3],p1[1]);a=max3f(a,p1[2],p1[3]);
  #pragma unroll
  for(int r=4;r<16;r+=4){a=max3f(a,p0[r],p0[r+1]);b=max3f(b,p0[r+2],p0[r+3]);a=max3f(a,p1[r],p1[r+1]);b=max3f(b,p1[r+2],p1[r+3]);}
  const float m=max2f(a,b);
  auto rr=__builtin_amdgcn_permlane32_swap(__float_as_uint(m),__float_as_uint(m),false,false);
  return max2f(__uint_as_float(rr[0]),__uint_as_float(rr[1]));
}
__device__ __forceinline__ void pv(f32x16*o,int vb,bf16x8 pa0,bf16x8 pa1,bf16x8 pa2,bf16x8 pa3){
  #pragma unroll
  for(int d0=0;d0<2;++d0){s16x4 lo[4],hi[4];
    #pragma unroll
    for(int ks=0;ks<4;++ks){
      asm volatile("ds_read_b64_tr_b16 %0,%1 offset:%c2":"=&v"(lo[ks]):"v"(vb),"i"(d0*4096+ks*1024):"memory");
      asm volatile("ds_read_b64_tr_b16 %0,%1 offset:%c2":"=&v"(hi[ks]):"v"(vb),"i"(d0*4096+ks*1024+512):"memory");}
    asm volatile("s_waitcnt lgkmcnt(0)":::"memory");SBAR();
    #define PK(k) (bf16x8){lo[k][0],lo[k][1],lo[k][2],lo[k][3],hi[k][0],hi[k][1],hi[k][2],hi[k][3]}
    o[d0]=__builtin_amdgcn_mfma_f32_32x32x16_bf16(pa0,PK(0),o[d0],0,0,0);
    o[d0]=__builtin_amdgcn_mfma_f32_32x32x16_bf16(pa1,PK(1),o[d0],0,0,0);
    o[d0]=__builtin_amdgcn_mfma_f32_32x32x16_bf16(pa2,PK(2),o[d0],0,0,0);
    o[d0]=__builtin_amdgcn_mfma_f32_32x32x16_bf16(pa3,PK(3),o[d0],0,0,0);
    #undef PK
  }
}

#ifndef ATTN_STORE16
#define ATTN_STORE16(p,v) (*(u32x4*)(p)=(v))
#endif
struct AttnPtrs { const bf16* Q; const bf16* K; const bf16* V; bf16* Z; const float* rpb; };
template<int THRL,int KIND,int NT> __device__ __forceinline__ void attn_unit(int b,int h,int blk,bool meta,const AttnPtrs&P,char*shm){
  int tid_=threadIdx.x; asm volatile("":"+v"(tid_));
  const int tid=tid_,lane=tid&63,r32=lane&31,hi=lane>>5; const int wid=__builtin_amdgcn_readfirstlane(tid>>6);
  const int wsrc=(KIND==0&&meta)?(wid&1):wid;
  int tok0,hrow0; const int NHK=(KIND==2)?8:2;
  if(KIND==2){ tok0=b*4096+(4*blk+(wid>>1))*64+(wid&1)*32; hrow0=h; }
  else if(!meta){ tok0=b*4096+blk*256+wid*32; hrow0=h; }
  else { tok0=NREAL+b*16; hrow0=4*h+2*wsrc; }
  const bool mrows=(KIND==0&&meta);
  #define ROW_TOK(row) (mrows?tok0+((row)&15):tok0+(row))
  #define ROW_HEAD(row) (mrows?hrow0+((row)>>4):hrow0)
  const int kvh=(KIND==2)?h:(meta?h:(h>>2));
  const bf16*Kh=P.K+(size_t)(b*NHK+kvh)*KVROWS*KVP,*Vh=P.V+(size_t)(b*NHK+kvh)*KVROWS*KVP;
  const int gy0=4*blk, gmin=(KIND==2)?min(max(gy0-4,0),53):0;
  const int qrw=gy0+(wid>>1), rsw=min(max(qrw-4,0),56);
  const int qc=(wid&1)*32+r32, csl=min(max(qc-8,0),48);
  const unsigned lds0=(unsigned)(uintptr_t)shm;
  float*wsf=(float*)(shm+LDS_WS)+wid*64;
  const bf16*ksrc=Kh+(long)lane*KVP+wid*8;
  const bf16*vsrc=Vh+(long)(16*(wid&3)+(lane>>2))*KVP+(wid>>2)*32+(lane&3)*8;
  const unsigned kdst=lds0+LDS_K+wid*1024, vdst=lds0+LDS_V+wid*1024;
  #define TROW(t) ((KIND==2)?(((t)==0)?0:KVBLK*(gmin+(t))):KVBLK*(t))
  #define DMA_K(t,slot) glds16(ksrc+(long)TROW(t)*KVP,(unsigned)__builtin_amdgcn_readfirstlane(kdst+(slot)))
  #define DMA_V(t,slot) glds16(vsrc+(long)TROW(t)*KVP,(unsigned)__builtin_amdgcn_readfirstlane(vdst+(slot)))
  const int vb0=(int)(lds0+LDS_V)+((lane>>4)&1)*32+(lane&3)*8+(4*hi+((lane&15)>>2))*64;
  const char*Kbase=shm+LDS_K; bf16x8 kf[8];
  const lds_cptr shm3=(lds_cptr)shm; const lds_cptr kp0=shm3+LDS_K+hi*1024+r32*16; const lds_cptr vp0=shm3+LDS_V+((lane>>4)&1)*32+(lane&3)*8+(4*hi+((lane&15)>>2))*64;
  DMA_K(0,0);DMA_V(0,0);DMA_K(1,SLOTB);
  bf16x8 qr[4];
  #pragma unroll
  for(int d0=0;d0<4;++d0)qr[d0]=*reinterpret_cast<const bf16x8*>(P.Q+(size_t)ROW_TOK(r32)*512+ROW_HEAD(r32)*64+d0*16+hi*8);
  float mhat=0.f,l_reg=0.f;f32x16 o[2];o[0]=f32x16{};o[1]=f32x16{};f32x16 negm=f32x16{};asm volatile("":"+v"(negm));
  typedef __attribute__((address_space(3))) float lds_f32;
  lds_f32*tab=(lds_f32*)(shm+LDS_TAB);
  if(KIND==2){ for(int i=tid;i<465;i+=NW*64)tab[64+i]=P.rpb[h*465+i]*1.4426950408889634f; }
  const int cbl=4*hi-csl; const lds_f32*bl0=tab+64+15-qc+4*hi;
  #define CMASK(P0,P1,t) do{ if(KIND==2){ const int kr_=gmin+(t)-1; na_mask(P0,P1,(kr_>=rsw)&&(kr_<rsw+8),cbl,bl0+(kr_-qrw+7)*31); } }while(0)
  bool resc=false;
  #define START(P0,P1) do{ const float rm=rowmax(P0,P1); resc=false; \
    { const float dl=rm; mhat=fadd_s(mhat,dl); \
      _Pragma("unroll") for(int r=0;r<16;++r){P0[r]=fsub_s(P0[r],dl);P1[r]=fsub_s(P1[r],dl);} \
      _Pragma("unroll") for(int r=0;r<16;++r)negm[r]=-mhat; asm volatile("":"+v"(negm)); } \
    _Pragma("unroll") for(int r=0;r<16;++r)P0[r]=__builtin_amdgcn_exp2f(P0[r]); }while(0)
  #define RESC() do{ if(resc){ asm volatile("s_waitcnt lgkmcnt(0)":::"memory"); \
      _Pragma("unroll") for(int d_=0;d_<2;++d_) _Pragma("unroll") for(int r=0;r<16;++r)o[d_][r]*=wsf[crow(r,hi)]; } }while(0)
  f32x16 pA0,pA1,pB0,pB1;
  int sl_prev=0,sl_cur=0,sl_next=SLOTB;
  #define ROT() do{sl_prev=sl_cur;sl_cur=sl_next;sl_next=(sl_next==(NSLOT-1)*SLOTB)?0:sl_next+SLOTB;}while(0)
  DMA_K(2,2*SLOTB);
  WAIT_BAR(3);
  qkt(pA0,pA1,Kbase,qr,negm,r32,hi);asm volatile("s_nop 15\n\ts_nop 7":"+v"(pA0),"+v"(pA1));mask_meta(pA0,pA1);
  START(pA0,pA1);
  _Pragma("unroll") for(int r=0;r<16;++r)pA1[r]=__builtin_amdgcn_exp2f(pA1[r]);
  WAIT_BAR(0);
  DMA_K(3,0);DMA_V(1,SLOTB);
  ROT();
  kload8(kf,kp0+sl_cur);
  WAIT_BAR(2);
  s16x4 vlo[8],vhi[8]; u32x4 pw0,pw1,pw2,pw3;
  #define PKW(P,B) cvtpk_s(P[B],P[B+1])
  #define PAF(k) __builtin_bit_cast(bf16x8,pw##k)
  #define VFR(i) (bf16x8){vlo[i][0],vlo[i][1],vlo[i][2],vlo[i][3],vhi[i][0],vhi[i][1],vhi[i][2],vhi[i][3]}
  #define PIN(x) asm volatile("":"+v"(x))
  #define MX3(a,b,c) __builtin_fmaxf(__builtin_fmaxf((a),(b)),(c))
  #define GAPA(MF,A0,A1,A2,A3,W0,W1,PW) do{ MF; sacc+=A0; sacc+=A1; sacc+=A2; sacc+=A3; PIN(sacc); W0; W1; PIN(PW); SBAR(); }while(0)
  #define EX(v) __builtin_amdgcn_exp2f(v)
  #define GAPB(MF,X,B) do{ MF; X[B]=EX(X[B]); X[B+1]=EX(X[B+1]); X[B+2]=EX(X[B+2]); X[B+3]=EX(X[B+3]); PIN(X); SBAR(); }while(0)
  #define VRD(i) do{ vlo[i]=vtr(vp_+(((i)>>2)*4096+((i)&3)*1024)); vhi[i]=vtr(vp_+(((i)>>2)*4096+((i)&3)*1024+512)); }while(0)
  #define KRD(G,j) do{ if(G){ kload2(kf,kp0+sl_next,j); SBAR(); } }while(0)
  #define STEP(C0,C1,P0,P1,t,GK,GV,GL) do{ SBAR(); \
    const lds_cptr vp_=vp0+sl_prev; \
    VRD(0); SBAR(); float sacc=(P0[0]+P0[1]); \
    GAPA(C0=__builtin_amdgcn_mfma_f32_32x32x16_bf16(kf[0],qr[0],negm,0,0,0), P0[2],P0[3],P0[4],P0[5],     pw0[0]=PKW(P0,0), pw0[1]=PKW(P0,2), pw0); \
    VRD(4); SBAR(); GAPA(C1=__builtin_amdgcn_mfma_f32_32x32x16_bf16(kf[1],qr[0],negm,0,0,0), P0[6],P0[7],P0[8],P0[9],     pw0[2]=PKW(P0,4), pw0[3]=PKW(P0,6), pw0); \
    VRD(1); SBAR(); GAPA(C0=__builtin_amdgcn_mfma_f32_32x32x16_bf16(kf[2],qr[1],C0,0,0,0),   P0[10],P0[11],P0[12],P0[13], pw1[0]=PKW(P0,8), pw1[1]=PKW(P0,10), pw1); \
    VRD(5); SBAR(); GAPA(C1=__builtin_amdgcn_mfma_f32_32x32x16_bf16(kf[3],qr[1],C1,0,0,0),   P0[14],P0[15],P1[0],P1[1],   pw1[2]=PKW(P0,12),pw1[3]=PKW(P0,14), pw1); \
    VRD(2); SBAR(); GAPA(C0=__builtin_amdgcn_mfma_f32_32x32x16_bf16(kf[4],qr[2],C0,0,0,0),   P1[2],P1[3],P1[4],P1[5],     pw2[0]=PKW(P1,0), pw2[1]=PKW(P1,2), pw2); \
    VRD(6); SBAR(); GAPA(C1=__builtin_amdgcn_mfma_f32_32x32x16_bf16(kf[5],qr[2],C1,0,0,0),   P1[6],P1[7],P1[8],P1[9],     pw2[2]=PKW(P1,4), pw2[3]=PKW(P1,6), pw2); \
    VRD(3); SBAR(); GAPA(C0=__builtin_amdgcn_mfma_f32_32x32x16_bf16(kf[6],qr[3],C0,0,0,0),   P1[10],P1[11],P1[12],P1[13], pw3[0]=PKW(P1,8), pw3[1]=PKW(P1,10), pw3); \
    VRD(7); SBAR(); GAPA(C1=__builtin_amdgcn_mfma_f32_32x32x16_bf16(kf[7],qr[3],C1,0,0,0),   P1[14],P1[15],0.f,0.f,       pw3[2]=PKW(P1,12),pw3[3]=PKW(P1,14), pw3); \
    l_reg+=sacc; \
    if(GK){DMA_K((t)+3,sl_cur);} if(GV){DMA_V((t)+1,sl_next);} \
    CMASK(C0,C1,t); \
    { float a=MX3(C0[0],C0[1],C1[0]),b=MX3(C0[2],C0[3],C1[1]); a=MX3(a,C1[2],C1[3]); \
      _Pragma("unroll") for(int r=4;r<16;r+=4){a=MX3(a,C0[r],C0[r+1]);b=MX3(b,C0[r+2],C0[r+3]);a=MX3(a,C1[r],C1[r+1]);b=MX3(b,C1[r+2],C1[r+3]);} \
      float rm=__builtin_fmaxf(a,b); { auto rr=__builtin_amdgcn_permlane32_swap(__float_as_uint(rm),__float_as_uint(rm),false,false); rm=__builtin_fmaxf(__uint_as_float(rr[0]),__uint_as_float(rr[1])); } \
      resc=false; \
      if(__builtin_expect(__any(rm>(float)THRL),0)){ const float dl=__builtin_fmaxf(rm,0.f); mhat+=dl; \
        _Pragma("unroll") for(int r=0;r<16;++r){C0[r]-=dl;C1[r]-=dl;} \
        _Pragma("unroll") for(int r=0;r<16;++r)negm[r]=-mhat; asm volatile("":"+v"(negm)); \
        const float f=__builtin_amdgcn_exp2f(-dl); l_reg*=f; if(hi==0)wsf[r32]=f; resc=true; } } \
    SBAR(); \
    GAPB(o[0]=__builtin_amdgcn_mfma_f32_32x32x16_bf16(PAF(0),VFR(0),o[0],0,0,0), C0,0); \
    GAPB(o[1]=__builtin_amdgcn_mfma_f32_32x32x16_bf16(PAF(0),VFR(4),o[1],0,0,0), C0,4); \
    KRD(GL,0); GAPB(o[0]=__builtin_amdgcn_mfma_f32_32x32x16_bf16(PAF(1),VFR(1),o[0],0,0,0), C0,8); \
    KRD(GL,1); GAPB(o[1]=__builtin_amdgcn_mfma_f32_32x32x16_bf16(PAF(1),VFR(5),o[1],0,0,0), C0,12); \
    KRD(GL,2); GAPB(o[0]=__builtin_amdgcn_mfma_f32_32x32x16_bf16(PAF(2),VFR(2),o[0],0,0,0), C1,0); \
    KRD(GL,3); GAPB(o[1]=__builtin_amdgcn_mfma_f32_32x32x16_bf16(PAF(2),VFR(6),o[1],0,0,0), C1,4); \
    GAPB(o[0]=__builtin_amdgcn_mfma_f32_32x32x16_bf16(PAF(3),VFR(3),o[0],0,0,0), C1,8); \
    GAPB(o[1]=__builtin_amdgcn_mfma_f32_32x32x16_bf16(PAF(3),VFR(7),o[1],0,0,0), C1,12); \
    }while(0)
  int t=1;
  for(;t+5<NT;t+=2){
    STEP(pB0,pB1,pA0,pA1,t,true,true,true);     WAIT_BAR(2); RESC(); ROT();
    STEP(pA0,pA1,pB0,pB1,t+1,true,true,true);   WAIT_BAR(2); RESC(); ROT();
  }
  #define ENDW(tt) do{ if((tt)+3<NT){WAIT_BAR(2);} else if((tt)+2<NT){WAIT_BAR(1);} else {WAIT_BAR(0);} }while(0)
  for(;t+1<NT;t+=2){
    STEP(pB0,pB1,pA0,pA1,t,(t+3<NT),(t+1<NT),(t+1<NT));       ENDW(t);   RESC(); ROT();
    STEP(pA0,pA1,pB0,pB1,t+1,(t+4<NT),(t+2<NT),(t+2<NT));     ENDW(t+1); RESC(); ROT();
  }
  #define DRAIN(PX0,PX1,SLOT) do{ float sacc=PX0[0]+PX0[1]; _Pragma("unroll") for(int r=2;r<16;++r)sacc+=PX0[r]; _Pragma("unroll") for(int r=0;r<16;++r)sacc+=PX1[r]; l_reg+=sacc; \
    pw0=(u32x4){PKW(PX0,0),PKW(PX0,2),PKW(PX0,4),PKW(PX0,6)};pw1=(u32x4){PKW(PX0,8),PKW(PX0,10),PKW(PX0,12),PKW(PX0,14)};pw2=(u32x4){PKW(PX1,0),PKW(PX1,2),PKW(PX1,4),PKW(PX1,6)};pw3=(u32x4){PKW(PX1,8),PKW(PX1,10),PKW(PX1,12),PKW(PX1,14)}; \
    SBAR(); pv(o,vb0+(SLOT),PAF(0),PAF(1),PAF(2),PAF(3)); }while(0)
  if constexpr((NT&1)==0){ STEP(pB0,pB1,pA0,pA1,NT-1,false,false,false); RESC(); DRAIN(pB0,pB1,sl_cur); }
  else { DRAIN(pA0,pA1,sl_prev); }
  #undef DRAIN
  #undef PKW
  #undef PAF
  #undef VFR
  #undef PIN
  #undef MX3
  #undef GAPA
  #undef GAPB
  #undef EX
  #undef VRD
  #undef KRD
  #undef STEP
  #undef ENDW
  {auto rr=__builtin_amdgcn_permlane32_swap(__float_as_uint(l_reg),__float_as_uint(l_reg),false,false);l_reg=__uint_as_float(rr[0])+__uint_as_float(rr[1]);}
  if(hi==0)wsf[32+r32]=l_reg;asm volatile("s_waitcnt lgkmcnt(0)":::"memory");
  float rli[16];
  #pragma unroll
  for(int r=0;r<16;++r)rli[r]=__builtin_amdgcn_rcpf(wsf[32+crow(r,hi)]);
  { bf16*stg=(bf16*)(shm+LDS_OST)+wid*2048;
    #pragma unroll
    for(int r=0;r<16;++r){const int orow=crow(r,hi);
      #pragma unroll
      for(int d0=0;d0<2;++d0)stg[orow*64+d0*32+r32]=__float2bfloat16(o[d0][r]*rli[r]);}
    asm volatile("s_waitcnt lgkmcnt(0)":::"memory");
    const bool dostore=!(KIND==0&&meta)||wid<2;
    #pragma unroll
    for(int i=0;i<4;++i){const int row=i*8+(lane>>3),ch=lane&7; const u32x4 v=*(const u32x4*)(stg+row*64+ch*8);
      bf16*zp=P.Z+(size_t)ROW_TOK(row)*1024+ROW_HEAD(row)*64+ch*8; const u32x4 z=*(const u32x4*)zp; u32x4 w;
      #pragma unroll
      for(int q=0;q<4;++q) w[q]=cvtpk_s(__uint_as_float(v[q]<<16)*__uint_as_float(z[q]<<16),__uint_as_float(v[q]&0xffff0000u)*__uint_as_float(z[q]&0xffff0000u));
      if(dostore)*(u32x4*)zp=w; } }
  asm volatile("s_waitcnt lgkmcnt(0)\n\ts_barrier":::"memory");
  #undef DMA_K
  #undef DMA_V
  #undef TROW
  #undef ROW_TOK
  #undef ROW_HEAD
  #undef CMASK
  #undef START
  #undef RESC
  #undef ROT
}
constexpr int ATTN_LDS_BYTES=LDS_BYTES;
#undef SBAR
#undef WAIT_BAR
}

#define GAS __attribute__((address_space(1)))
#define LAS __attribute__((address_space(3)))
typedef GAS unsigned gu32;
#define RLX_AGENT __ATOMIC_RELAXED, __HIP_MEMORY_SCOPE_AGENT
#define LDS_WAIT() asm volatile("s_waitcnt lgkmcnt(0)" ::: "memory")
#define VM_WAIT() asm volatile("s_waitcnt vmcnt(0)" ::: "memory")
#define XB_TMO      128
#define XB_XCNT(j)  (256  + 64 * (j))
#define XB_XSUB(j)  (1280 + 64 * (j))
#define XB_XGEN(j)  (2304 + 64 * (j))
#define XB_TOP      3328
#define XB_TOPGEN   3392
#define XCD_BAR_WORDS 3456
#define XB_SPIN_CAP (1u << 18)

__device__ __forceinline__ unsigned xb_ld(unsigned* p)              { return __hip_atomic_load(p, __ATOMIC_RELAXED, __HIP_MEMORY_SCOPE_AGENT); }
__device__ __forceinline__ unsigned xb_add(unsigned* p, unsigned v) { return __hip_atomic_fetch_add(p, v, __ATOMIC_RELAXED, __HIP_MEMORY_SCOPE_AGENT); }
__device__ __forceinline__ unsigned xb_xcc_id() { return (unsigned)__builtin_amdgcn_s_getreg((3 << 11) | 20) & 0xFu; }
#define XB_SPIN(cond, bar) do { unsigned _sp = 0; while (cond) { __builtin_amdgcn_s_sleep(1); \
    if ((++_sp & 255u) == 0u) { if (xb_ld(&(bar)[XB_TMO])) break; if (_sp > XB_SPIN_CAP) { atomicAdd(&(bar)[XB_TMO], 1u); break; } } } } while (0)

struct XcdBarrier {
    unsigned* bar; unsigned x;
    volatile LAS unsigned* st;
};

__device__ __forceinline__ XcdBarrier xcd_barrier_post(unsigned* bar, volatile LAS unsigned* st) {
    XcdBarrier b; b.bar = bar; b.x = xb_xcc_id(); b.st = st;
    if (threadIdx.x == 0) (void)xb_add(&bar[XB_XCNT(b.x)], 1u);
    return b;
}
__device__ __forceinline__ void xcd_barrier_complete(unsigned* bar, unsigned x, unsigned& nloc, unsigned& nx) {
    const unsigned G = gridDim.x * gridDim.y * gridDim.z;
    unsigned sum, cnt, mine, sp = 0u;
    for (;;) {
        sum = 0u; cnt = 0u; mine = 0u;
#pragma unroll
        for (unsigned j = 0; j < 16; ++j) { const unsigned c = xb_ld(&bar[XB_XCNT(j)]); sum += c; cnt += (c > 0u) ? 1u : 0u; mine = (j == x) ? c : mine; }
        if (sum == G) break;
        __builtin_amdgcn_s_sleep(1);
        if ((++sp & 255u) == 0u) { if (xb_ld(&bar[XB_TMO])) break; if (sp > XB_SPIN_CAP) { atomicAdd(&bar[XB_TMO], 1u); break; } }
    }
    nloc = mine > 0u ? mine : 1u; nx = cnt > 0u ? cnt : 1u;
}

__device__ __forceinline__ void xcd_barrier(const XcdBarrier& b) {
    asm volatile("s_waitcnt vmcnt(0)" ::: "memory");
    __syncthreads();
    if (threadIdx.x == 0) {
        unsigned* bar = b.bar;
        __builtin_amdgcn_s_waitcnt(0);
        unsigned nloc = b.st[0], nx = b.st[1];
        if (nloc == 0u) { xcd_barrier_complete(bar, b.x, nloc, nx); b.st[0] = nloc; b.st[1] = nx; }
        const unsigned old = xb_add(&bar[XB_XSUB(b.x)], 1u);
        const unsigned gen = old / nloc;
        if (old + 1u == (gen + 1u) * nloc) {
            __builtin_amdgcn_fence(__ATOMIC_RELEASE, "agent");
            asm volatile("s_waitcnt vmcnt(0)" ::: "memory");
            const unsigned og = xb_add(&bar[XB_TOP], 1u);
            const unsigned tg = og / nx;
            if (og + 1u == (tg + 1u) * nx) xb_add(&bar[XB_TOPGEN], 1u);
            else XB_SPIN(xb_ld(&bar[XB_TOPGEN]) == tg, bar);
            __builtin_amdgcn_fence(__ATOMIC_ACQUIRE, "agent");
            xb_add(&bar[XB_XGEN(b.x)], 1u);
            asm volatile("s_waitcnt vmcnt(0)" ::: "memory");
        } else {
            XB_SPIN(xb_ld(&bar[XB_XGEN(b.x)]) == gen, bar);
            __builtin_amdgcn_fence(__ATOMIC_ACQUIRE, "agent");
            asm volatile("s_waitcnt vmcnt(0)" ::: "memory");
        }
    }
    __syncthreads();
}

constexpr int NWAVES = 8;
constexpr int RING_BYTES = 131072, LDSCTL_OFF = RING_BYTES, MISC_OFF = LDSCTL_OFF + 320, LDS_BYTES = 147456;
constexpr int CW_BAR = 4096;
constexpr size_t CTL_ZERO_BYTES = 1 * MiB;
constexpr int N_PHASES = 10;
static_assert(attn_body::ATTN_LDS_BYTES <= RING_BYTES, "attention scratch fits the ring region");
static_assert((CW_BAR + N_PHASES * XCD_BAR_WORDS) * 4 <= (int)CTL_ZERO_BYTES, "barrier words inside the memset block");

struct MkArgs { const float* in[11]; float* out; unsigned char* ws; int ph_lo, ph_hi, li, pad; };

__device__ __forceinline__ int head_slot(int cw) { const int wc = cw >> 6, d = cw & 63; return 128 * ((d >> 4) & 1) + 32 * wc + 16 * ((d >> 2) & 1) + 8 * (d >> 5) + 4 * ((d >> 3) & 1) + (d & 3); }
__device__ __forceinline__ int elem_slot(int cw) { const int e = cw & 31; return (cw & ~31) + 16 * ((e >> 2) & 1) + 4 * (e >> 3) + (e & 3); }
__device__ __forceinline__ int in_slot(int ncol) { const int t = ncol >> 8, cw = ncol & 255; const bool head = (t < 3) || (t >= 5 && t < 11); return t * 256 + (head ? head_slot(cw) : elem_slot(cw)); }

template <bool INMAP> __device__ __forceinline__ void p0_transpose_item(const float* W, int K, int N, bf16_t* WT, int ldk, int koff, LAS float* scr, int item, int lane) {
    const int nblk = N / 32, kb = item / nblk, nb = item % nblk, k0 = 64 * kb, n0 = 32 * nb;
#pragma unroll 8
    for (int i = 0; i < 32; ++i) { const int kk = 2 * i + (lane >> 5); scr[kk * 33 + (lane & 31)] = W[(size_t)(k0 + kk) * N + n0 + (lane & 31)]; }
    LDS_WAIT(); asm volatile("" ::: "memory");
    const int c = lane & 7;
#pragma unroll
    for (int j = 0; j < 4; ++j) { const int n = (lane >> 3) + 8 * j; const LAS float* s = scr + (8 * c) * 33 + n;
        u32x4 o; o.x = pk2(s[0 * 33], s[1 * 33]); o.y = pk2(s[2 * 33], s[3 * 33]); o.z = pk2(s[4 * 33], s[5 * 33]); o.w = pk2(s[6 * 33], s[7 * 33]);
        const int nc = n0 + n, row = INMAP ? in_slot(nc) : ((nc & ~255) + elem_slot(nc & 255));
        *(u32x4*)(WT + (size_t)row * ldk + koff + k0 + 8 * c) = o; }
    LDS_WAIT(); asm volatile("" ::: "memory");
}

struct Ptrs {
    const float *x, *meta, *norm_g, *w_in, *qng, *kng, *rpb, *w_oa, *w_ob, *w_out, *fin_g; float* out;
    float *rope, *HM, *rowp; bf16_t *WinP, *WoC, *WoutP, *XN, *QA, *QB, *MIX, *Z, *KA, *VA, *KB, *VB, *GA, *GB;
};
__device__ __forceinline__ void p0_prologue(const Ptrs& P, LAS unsigned char* lds, int vcu, int G, int wave, int lane) {
    LAS float* scr = (LAS float*)(lds + wave * 16384);
    const int gw = vcu * NWAVES + wave, NGW = G * NWAVES;
    constexpr int I_IN = (DM / 64) * (INC / 32), I_O = (512 / 64) * (DM / 32), I_OUT = (DM / 64) * (DM / 32), I_L = I_IN + 2 * I_O + I_OUT;
    for (int it = gw; it < 2 * I_L; it += NGW) {
        const int l = it / I_L; int r = it % I_L;
        if (r < I_IN) { p0_transpose_item<true>(P.w_in + (size_t)l * DM * INC, DM, INC, P.WinP + (size_t)l * INC * DM, DM, 0, scr, r, lane); continue; } r -= I_IN;
        if (r < I_O) { p0_transpose_item<false>(P.w_oa + (size_t)l * 512 * DM, 512, DM, P.WoC + (size_t)l * DM * DM, DM, 0, scr, r, lane); continue; } r -= I_O;
        if (r < I_O) { p0_transpose_item<false>(P.w_ob + (size_t)l * 512 * DM, 512, DM, P.WoC + (size_t)l * DM * DM, DM, 512, scr, r, lane); continue; } r -= I_O;
        p0_transpose_item<false>(P.w_out + (size_t)l * DM * DM, DM, DM, P.WoutP + (size_t)l * DM * DM, DM, 0, scr, r, lane);
    }
    for (int r = gw; r < NTOK; r += NGW) {
        const float* src = (r < NREAL) ? P.x + (size_t)r * DM : P.meta + (size_t)((r - NREAL) & 15) * DM;
        float ss = 0.f; f32x4 v[4];
#pragma unroll
        for (int j = 0; j < 4; ++j) { v[j] = *(const f32x4*)(src + 256 * j + 4 * lane); ss += (v[j].x * v[j].x + v[j].y * v[j].y) + (v[j].z * v[j].z + v[j].w * v[j].w); }
        ss = wave_sum(ss);
#pragma unroll
        for (int j = 0; j < 4; ++j) { const f32x4 gg = *(const f32x4*)(P.norm_g + 256 * j + 4 * lane); u32x2 o; o.x = pk2(v[j].x * gg.x, v[j].y * gg.y); o.y = pk2(v[j].z * gg.z, v[j].w * gg.w); *(u32x2*)(P.XN + (size_t)r * DM + 256 * j + 4 * lane) = o; }
        if (lane < 16) P.rowp[(size_t)r * 16 + lane] = lane ? 0.f : ss;
    }
    const int gt = gw * 64 + lane, nt = NGW * 64;
    for (int i = gt; i < 64 * 16; i += nt) { const int pos = i >> 4, k = i & 15; const float inv = powf(10000.f, -(float)k / 16.f); const float a = (float)pos * inv; P.rope[i] = cosf(a); P.rope[1024 + i] = sinf(a); }
    for (int i = gt; i < NB * 2 * 3072; i += nt) { const int hh = i / 3072, e = i % 3072; P.KA[(size_t)hh * KVROWS * 64 + 1024 + e] = 0; P.VA[(size_t)hh * KVROWS * 64 + 1024 + e] = 0; }
    for (int i = gt; i < NB * 8 * 3072; i += nt) { const int hh = i / 3072, e = i % 3072; P.KB[(size_t)hh * KVROWS * 64 + 1024 + e] = 0; P.VB[(size_t)hh * KVROWS * 64 + 1024 + e] = 0; }
    for (int i = gt; i < (MPAD - NTOK) * 1024; i += nt) { P.XN[(size_t)NTOK * 1024 + i] = 0; P.Z[(size_t)NTOK * 1024 + i] = 0; }
    for (int i = gt; i < 3 * (MPAD - NTOK) * 16; i += nt) { const int st = i / ((MPAD - NTOK) * 16), e = i % ((MPAD - NTOK) * 16); P.rowp[((size_t)st * MPAD + NTOK) * 16 + e] = (e & 15) ? 0.f : 1024.f; }
}

__device__ __forceinline__ void na_meta_wave(int b, int h, const Ptrs& P, int lane) {
    const int q = lane & 15, dq = lane >> 4, tok = NREAL + b * 16 + q;
    float qv[16], o[16], s[16];
    { const bf16_t* qp = P.QB + (size_t)tok * 512 + h * 64 + 16 * dq;
#pragma unroll
      for (int c = 0; c < 2; ++c) { const u32x4 v = *(const u32x4*)(qp + 8 * c);
#pragma unroll
        for (int e = 0; e < 4; ++e) { qv[8 * c + 2 * e] = bf2f(v[e] & 0xffff); qv[8 * c + 2 * e + 1] = bf2f(v[e] >> 16); } } }
    const bf16_t* Kh = P.KB + (size_t)(b * 8 + h) * KVROWS * 64 + 16 * dq; const bf16_t* Vh = P.VB + (size_t)(b * 8 + h) * KVROWS * 64 + 16 * dq;
    float mx = -INFINITY;
#pragma unroll
    for (int j = 0; j < 16; ++j) { float acc = 0.f;
#pragma unroll
        for (int c = 0; c < 2; ++c) { const u32x4 v = *(const u32x4*)(Kh + j * 64 + 8 * c);
#pragma unroll
            for (int e = 0; e < 4; ++e) acc += qv[8 * c + 2 * e] * bf2f(v[e] & 0xffff) + qv[8 * c + 2 * e + 1] * bf2f(v[e] >> 16); }
        acc += __shfl_xor(acc, 16); acc += __shfl_xor(acc, 32); s[j] = acc; mx = fmaxf(mx, acc); }
    float l = 0.f;
#pragma unroll
    for (int i = 0; i < 16; ++i) o[i] = 0.f;
#pragma unroll
    for (int j = 0; j < 16; ++j) { const float p = exp2f(s[j] - mx); l += p;
#pragma unroll
        for (int c = 0; c < 2; ++c) { const u32x4 v = *(const u32x4*)(Vh + j * 64 + 8 * c);
#pragma unroll
            for (int e = 0; e < 4; ++e) { o[8 * c + 2 * e] += p * bf2f(v[e] & 0xffff); o[8 * c + 2 * e + 1] += p * bf2f(v[e] >> 16); } } }
    const float inv = 1.f / l; bf16_t* zp = P.Z + (size_t)tok * 1024 + 512 + h * 64 + 16 * dq;
#pragma unroll
    for (int c = 0; c < 2; ++c) { const u32x4 z = *(const u32x4*)(zp + 8 * c); u32x4 w;
#pragma unroll
        for (int e = 0; e < 4; ++e) w[e] = pk2(o[8 * c + 2 * e] * inv * bf2f(z[e] & 0xffff), o[8 * c + 2 * e + 1] * inv * bf2f(z[e] >> 16));
        *(u32x4*)(zp + 8 * c) = w; }
}

typedef const __attribute__((address_space(4))) MkArgs* KArgP;
__device__ __forceinline__ KArgP kargs() { KArgP p = (KArgP)__builtin_amdgcn_kernarg_segment_ptr(); asm volatile("" : "+s"(p)); return p; }
__device__ __forceinline__ Ptrs make_ptrs() {
    KArgP a = kargs(); Ptrs P; unsigned char* ws = a->ws;
    P.x = a->in[0]; P.meta = a->in[1]; P.norm_g = a->in[2]; P.w_in = a->in[3]; P.qng = a->in[4]; P.kng = a->in[5]; P.rpb = a->in[6];
    P.w_oa = a->in[7]; P.w_ob = a->in[8]; P.w_out = a->in[9]; P.fin_g = a->in[10]; P.out = a->out;
    P.rope = (float*)(ws + WS_ROPE); P.HM = (float*)(ws + WS_HM); P.rowp = (float*)(ws + WS_ROWP);
    P.WinP = (bf16_t*)(ws + WS_WIN_P); P.WoC = (bf16_t*)(ws + WS_WOC); P.WoutP = (bf16_t*)(ws + WS_WOUT_P); P.XN = (bf16_t*)(ws + WS_XN);
    P.QA = (bf16_t*)(ws + WS_QA); P.QB = (bf16_t*)(ws + WS_QB); P.MIX = (bf16_t*)(ws + WS_MIX); P.Z = (bf16_t*)(ws + WS_Z);
    P.KA = (bf16_t*)(ws + WS_KA); P.VA = (bf16_t*)(ws + WS_VA); P.KB = (bf16_t*)(ws + WS_KB); P.VB = (bf16_t*)(ws + WS_VB); P.GA = (bf16_t*)(ws + WS_GA); P.GB = (bf16_t*)(ws + WS_GB);
    return P;
}
__global__ void __launch_bounds__(NWAVES * 64, 2) mk_fwd(MkArgs args) {
    extern __shared__ __attribute__((aligned(16))) unsigned char lds[];
    LAS unsigned char* L = (LAS unsigned char*)lds;
    volatile LAS unsigned* MISC = (volatile LAS unsigned*)(L + MISC_OFF);
    const int tid = threadIdx.x;
    const int G = gridDim.x; const int bx = blockIdx.x;
    const int vcu_ = (G % 8 == 0) ? (bx % 8) * (G / 8) + bx / 8 : bx;
#define VCU vcu_
#define WAVE (__builtin_amdgcn_readfirstlane((int)threadIdx.x >> 6))
#define LANE ([]() __attribute__((always_inline)) { int t_ = threadIdx.x; asm volatile("" : "+v"(t_)); return t_ & 63; }())
    for (int u = tid; u < (LDS_BYTES - LDSCTL_OFF) / 4; u += NWAVES * 64) ((LAS unsigned*)(L + LDSCTL_OFF))[u] = 0u;
    __syncthreads();
    XcdBarrier bar = xcd_barrier_post((unsigned*)(args.ws + WS_CTL) + CW_BAR + args.li * XCD_BAR_WORDS, MISC + 8);
    const int lo = args.ph_lo, hi = args.ph_hi;
#define IN(k) (lo <= (k) && (k) < hi)
#define SEAM(k) do { if (IN(k) && IN((k) + 1)) xcd_barrier(bar); } while (0)

    if (IN(0)) { const Ptrs P = make_ptrs(); p0_prologue(P, L, VCU, G, WAVE, LANE); SEAM(0); }

#pragma unroll 1
    for (int l = 0; l < 2; ++l) {
        const int pb = 1 + 4 * l;
        if (IN(pb)) {
            const Ptrs P = make_ptrs();
            pg8::Gemm g{P.XN, P.WinP + (size_t)l * INC * DM, MPAD, INC, DM}; pg8::StaticOrder S; S.init(MPAD, INC, G, bx);
            pg8::EpiIn E{P.rowp + (size_t)l * MPAD * 16, P.qng + l * 64, P.kng + l * 64, P.rope, P.QA, P.KA, P.VA, P.Z, P.QB, P.KB, P.VB, P.GA, P.GB};
            pg8::gemm_phase<pg8::EpiIn, pg8::StaticOrder, true, true>(L, g, S, E);
            SEAM(pb);
        }
        if (IN(pb + 1)) {
            { const Ptrs P = make_ptrs(); const int vcu = VCU;
              const attn_body::AttnPtrs PA{(const attn_body::bf16*)P.QA, (const attn_body::bf16*)P.KA, (const attn_body::bf16*)P.VA, (attn_body::bf16*)P.Z, nullptr};
              const int nun = (l == 0 && vcu < 16) ? 5 : 4;
#pragma unroll 1
              for (int i = 0; i < nun; ++i) {
                const bool meta = i == 4; const int pair = meta ? vcu : (vcu >> 4), qb = vcu & 15;
                attn_body::attn_unit<8, 0, 65>(pair >> 1, meta ? (pair & 1) : 4 * (pair & 1) + i, qb, meta, PA, (char*)lds);
              } }
            { const Ptrs P = make_ptrs(); const int vcu = VCU;
              const attn_body::AttnPtrs PB{(const attn_body::bf16*)P.QB, (const attn_body::bf16*)P.KB, (const attn_body::bf16*)P.VB, (attn_body::bf16*)(P.Z + 512), P.rpb + (size_t)l * 8 * 465};
#pragma unroll 1
              for (int u = vcu; u < 1024; u += G) {
                const int bh = (u & 255) >> 2, blk = 4 * (u & 3) + (u >> 8);
                attn_body::attn_unit<8, 2, 12>(bh >> 3, bh & 7, blk, false, PB, (char*)lds);
              }
              if (l == 0) { const int ln = LANE; for (int u = vcu * NWAVES + WAVE; u < 64; u += G * NWAVES) na_meta_wave(u >> 3, u & 7, P, ln); } }
            SEAM(pb + 1);
        }
        if (IN(pb + 2)) {
            const Ptrs P = make_ptrs();
            pg8::Gemm g{P.Z, P.WoC + (size_t)l * DM * DM, MPAD, DM, DM}; pg8::StaticOrder S; S.init(MPAD, DM, G, bx);
            pg8::EpiMix E{P.GA, P.GB, P.MIX};
            pg8::gemm_phase<pg8::EpiMix, pg8::StaticOrder, true, true>(L, g, S, E);
            SEAM(pb + 2);
        }
        if (IN(pb + 3)) {
            const Ptrs P = make_ptrs();
            pg8::Gemm g{P.MIX, P.WoutP + (size_t)l * DM * DM, MPAD, DM, DM}; pg8::StaticOrder S; S.init(MPAD, DM, G, bx);
            pg8::EpiOut E;
            if (l == 0) E = pg8::EpiOut{P.x, P.meta, 1, P.out, P.HM, P.norm_g + DM, P.XN, P.rowp + (size_t)1 * MPAD * 16};
            else E = pg8::EpiOut{P.out, P.HM, 0, P.out, nullptr, nullptr, nullptr, P.rowp + (size_t)2 * MPAD * 16};
            pg8::gemm_phase<pg8::EpiOut, pg8::StaticOrder, true, true>(L, g, S, E);
            SEAM(pb + 3);
        }
    }
    if (IN(9)) {
        const Ptrs P = make_ptrs(); const int lane = LANE;
        const float* rp = P.rowp + (size_t)2 * MPAD * 16;
        for (int r = VCU * NWAVES + WAVE; r < NREAL; r += G * NWAVES) {
            const float rstd = pg8::rowp_rstd(rp, r); float* p = P.out + (size_t)r * DM;
#pragma unroll
            for (int j = 0; j < 4; ++j) { const f32x4 v = *(const f32x4*)(p + 256 * j + 4 * lane), gg = *(const f32x4*)(P.fin_g + 256 * j + 4 * lane); *(f32x4*)(p + 256 * j + 4 * lane) = v * rstd * gg; }
        }
    }
#undef IN
#undef SEAM
#undef VCU
#undef WAVE
#undef LANE
}

#ifndef OPT_MASK
#define OPT_MASK 0x3FF
#endif
#ifndef FORCE_HYBRID
#define FORCE_HYBRID 0
#endif
extern "C" void kernel_launch(void* const* d_in, const int* in_sizes, int n_in, void* d_out, int out_size, void* d_ws, size_t ws_size, hipStream_t stream) {
    static int grid = 0;
    if (grid == 0) {
        if (n_in != 11 || ws_size < WS_END || out_size != NREAL * DM) { fprintf(stderr, "kernel_launch: unexpected shapes (n_in %d, ws %zu, out %d)\n", n_in, ws_size, out_size); grid = -1; return; }
        int dev = 0, cus = 0, per_cu = 0;
        if (hipGetDevice(&dev) != hipSuccess || hipDeviceGetAttribute(&cus, hipDeviceAttributeMultiprocessorCount, dev) != hipSuccess) { grid = -1; return; }
        if (hipFuncSetAttribute((const void*)mk_fwd, hipFuncAttributeMaxDynamicSharedMemorySize, LDS_BYTES) != hipSuccess) { fprintf(stderr, "kernel_launch: hipFuncSetAttribute failed\n"); grid = -1; return; }
        if (hipOccupancyMaxActiveBlocksPerMultiprocessor(&per_cu, (const void*)mk_fwd, NWAVES * 64, LDS_BYTES) != hipSuccess || per_cu < 1) { fprintf(stderr, "kernel_launch: occupancy query says %d blocks per CU\n", per_cu); (void)hipGetLastError(); }
        grid = cus;
    }
    if (grid < 0) return;
    const float* x = (const float*)d_in[0]; const float* meta = (const float*)d_in[1]; const float* norm_g = (const float*)d_in[2]; const float* w_in = (const float*)d_in[3];
    const float* qng = (const float*)d_in[4]; const float* kng = (const float*)d_in[5]; const float* rpb = (const float*)d_in[6];
    const float* w_oa = (const float*)d_in[7]; const float* w_ob = (const float*)d_in[8]; const float* w_out = (const float*)d_in[9]; const float* fin_g = (const float*)d_in[10];
    unsigned char* ws = (unsigned char*)d_ws; float* out = (float*)d_out;
    (void)hipMemsetAsync(ws + WS_CTL, 0, CTL_ZERO_BYTES, stream);
    MkArgs a{};
    for (int i = 0; i < 11; ++i) a.in[i] = (const float*)d_in[i];
    a.out = out; a.ws = ws;
    if (OPT_MASK == 0x3FF && !FORCE_HYBRID) {
        a.ph_lo = 0; a.ph_hi = N_PHASES; a.li = 0;
        hipLaunchKernelGGL(mk_fwd, dim3(grid), dim3(NWAVES * 64), LDS_BYTES, stream, a);
        return;
    }
    float* rowp = (float*)(ws + WS_ROWP); float* rope = (float*)(ws + WS_ROPE); float* HM = (float*)(ws + WS_HM);
    bf16_t* WinN = (bf16_t*)(ws + WS_WIN_N); bf16_t* WoA = (bf16_t*)(ws + WS_WOA); bf16_t* WoB = (bf16_t*)(ws + WS_WOB); bf16_t* Wout = (bf16_t*)(ws + WS_WOUT);
    bf16_t* XN = (bf16_t*)(ws + WS_XN); bf16_t* QA = (bf16_t*)(ws + WS_QA); bf16_t* QB = (bf16_t*)(ws + WS_QB); bf16_t* MIX = (bf16_t*)(ws + WS_MIX); bf16_t* Z = (bf16_t*)(ws + WS_Z);
    bf16_t* KA = (bf16_t*)(ws + WS_KA); bf16_t* VA = (bf16_t*)(ws + WS_VA); bf16_t* KB = (bf16_t*)(ws + WS_KB); bf16_t* VB = (bf16_t*)(ws + WS_VB); bf16_t* GA = (bf16_t*)(ws + WS_GA); bf16_t* GB = (bf16_t*)(ws + WS_GB);
    auto mk = [&](int p) { a.ph_lo = p; a.ph_hi = p + 1; a.li = p; hipLaunchKernelGGL(mk_fwd, dim3(grid), dim3(NWAVES * 64), LDS_BYTES, stream, a); };
    for (int l = 0; l < 2; ++l) {
        k_transpose<<<dim3(INC / 32, DM / 32), 256, 0, stream>>>(w_in + (size_t)l * DM * INC, WinN + (size_t)l * INC * DM, DM, INC);
        k_transpose<<<dim3(DM / 32, 512 / 32), 256, 0, stream>>>(w_oa + (size_t)l * 512 * DM, WoA + (size_t)l * DM * 512, 512, DM);
        k_transpose<<<dim3(DM / 32, 512 / 32), 256, 0, stream>>>(w_ob + (size_t)l * 512 * DM, WoB + (size_t)l * DM * 512, 512, DM);
        k_transpose<<<dim3(DM / 32, DM / 32), 256, 0, stream>>>(w_out + (size_t)l * DM * DM, Wout + (size_t)l * DM * DM, DM, DM);
    }
    if (OPT_MASK != 0) mk(0);
    if (!(OPT_MASK & 1)) { k_misc<<<256, 256, 0, stream>>>(rope, KA, VA, KB, VB, XN, Z, rowp); k_rownorm<<<NTOK / 4, 256, 0, stream>>>(x, meta, 1, norm_g, XN, rowp); }
    for (int l = 0; l < 2; ++l) {
        const int pb = 1 + 4 * l;
        if ((OPT_MASK >> pb) & 1) mk(pb);
        else { InArgs ia{XN, WinN + (size_t)l * INC * DM, rowp + (size_t)l * MPAD * 16, qng + l * 64, kng + l * 64, rope, QA, KA, VA, Z, QB, KB, VB, GA, GB}; k_inproj_naive<<<dim3(INC / 64, MPAD / 64), 256, 0, stream>>>(ia); }
        if ((OPT_MASK >> (pb + 1)) & 1) mk(pb + 1);
        else { k_gqa_naive<<<dim3(17, 8, NB), 256, 0, stream>>>(QA, KA, VA, Z); k_na_naive<<<dim3(65, 8, NB), 64, 0, stream>>>(QB, KB, VB, Z + 512, rpb + (size_t)l * 8 * 15 * 31); }
        if ((OPT_MASK >> (pb + 2)) & 1) mk(pb + 2);
        else k_mix_naive<<<dim3(DM / 64, MPAD / 64), 256, 0, stream>>>(Z, Z + 512, WoA + (size_t)l * DM * 512, WoB + (size_t)l * DM * 512, GA, GB, MIX);
        if ((OPT_MASK >> (pb + 3)) & 1) mk(pb + 3);
        else if (l == 0) { k_out_naive<<<dim3(DM / 64, MPAD / 64), 256, 0, stream>>>(MIX, Wout, x, meta, 1, out, HM); k_rownorm<<<NTOK / 4, 256, 0, stream>>>(out, HM, 0, norm_g + DM, XN, rowp + (size_t)MPAD * 16); }
        else { k_out_naive<<<dim3(DM / 64, MPAD / 64), 256, 0, stream>>>(MIX, Wout + (size_t)DM * DM, out, HM, 0, out, nullptr); k_rownorm<<<NTOK / 4, 256, 0, stream>>>(out, HM, 0, fin_g, XN, rowp + (size_t)2 * MPAD * 16); }
    }
    if ((OPT_MASK >> 9) & 1) mk(9); else k_final<<<NREAL / 4, 256, 0, stream>>>(out, fin_g);
}
```

```cpp
#include <hip/hip_runtime.h>
#include <cstdio>
#include <cstdint>
#include <cmath>

typedef unsigned short bf16_t;
typedef short bf16x8 __attribute__((ext_vector_type(8)));
typedef float f32x4 __attribute__((ext_vector_type(4)));
typedef unsigned u32x4 __attribute__((ext_vector_type(4)));
typedef unsigned u32x2 __attribute__((ext_vector_type(2)));

constexpr int DM = 1024, NB = 8, SEQ = 4096, NMETA = 16;
constexpr int NREAL = NB * SEQ;
constexpr int NTOK = NREAL + NB * NMETA;
constexpr int MPAD = 33024;
constexpr int INC = 5376;
constexpr int KVROWS = 4160;
constexpr float EPS = 1e-6f;
constexpr float LOG2E = 1.4426950408889634f;
constexpr float C2 = 0.125f * LOG2E;
constexpr int C_QA = 0, C_KA = 512, C_VA = 640, C_ZA = 768, C_QB = 1280, C_KB = 1792, C_VB = 2304, C_ZB = 2816, C_GA = 3328, C_GB = 4352;

constexpr size_t MiB = 1u << 20;
constexpr size_t WS_CTL = 0, WS_ROPE = 1 * MiB, WS_HM = 3 * MiB;
constexpr size_t WS_WIN_N = 4 * MiB, WS_WIN_P = 25 * MiB, WS_WOA = 46 * MiB, WS_WOB = 48 * MiB, WS_WOUT = 50 * MiB, WS_WOC = 54 * MiB, WS_WOUT_P = 58 * MiB;
constexpr size_t WS_XN = 62 * MiB, WS_QA = 127 * MiB, WS_QB = 160 * MiB, WS_MIX = 127 * MiB;
constexpr size_t WS_Z = 193 * MiB, WS_KA = 258 * MiB, WS_VA = 267 * MiB, WS_KB = 276 * MiB, WS_VB = 309 * MiB;
constexpr size_t WS_GA = 342 * MiB, WS_GB = 407 * MiB, WS_ROWP = 472 * MiB, WS_END = 479 * MiB;

__device__ __forceinline__ unsigned f2bf(float f) { unsigned u = __builtin_bit_cast(unsigned, f); return (u + 0x7fffu + ((u >> 16) & 1u)) >> 16; }
__device__ __forceinline__ float bf2f(unsigned h) { return __builtin_bit_cast(float, h << 16); }
__device__ __forceinline__ unsigned pk2(float lo, float hi) { return f2bf(lo) | (f2bf(hi) << 16); }
__device__ __forceinline__ float wave_sum(float v) {
#pragma unroll
    for (int o = 1; o < 64; o <<= 1) v += __shfl_xor(v, o);
    return v;
}
__device__ __forceinline__ float sigmoidf_(float x) { return 1.f / (1.f + __expf(-x)); }

struct RowInfo { int b, lp, gy, gx; bool valid; };
__device__ __forceinline__ RowInfo row_info(int r) {
    RowInfo i;
    if (r < NREAL) { i.b = r >> 12; const int s = r & 4095; i.lp = 64 + s; i.gy = s >> 6; i.gx = s & 63; i.valid = true; }
    else { const int q = r - NREAL; i.b = (q >> 4) & 7; i.lp = q & 15; i.gy = 0; i.gx = 0; i.valid = r < NTOK; }
    return i;
}

__global__ void __launch_bounds__(256) k_transpose(const float* __restrict__ W, bf16_t* __restrict__ Wt, int K, int N) {
    __shared__ float tile[32][33];
    const int n0 = blockIdx.x * 32, k0 = blockIdx.y * 32, tx = threadIdx.x & 31, ty = threadIdx.x >> 5;
#pragma unroll
    for (int i = 0; i < 4; ++i) tile[ty + 8 * i][tx] = W[(size_t)(k0 + ty + 8 * i) * N + n0 + tx];
    __syncthreads();
#pragma unroll
    for (int i = 0; i < 4; ++i) Wt[(size_t)(n0 + ty + 8 * i) * K + k0 + tx] = (bf16_t)f2bf(tile[tx][ty + 8 * i]);
}
__global__ void __launch_bounds__(256) k_misc(float* rope, bf16_t* KA, bf16_t* VA, bf16_t* KB, bf16_t* VB, bf16_t* XN, bf16_t* Z, float* rowss) {
    const int gt = blockIdx.x * 256 + threadIdx.x, nt = gridDim.x * 256;
    for (int i = gt; i < 64 * 16; i += nt) { const int pos = i >> 4, k = i & 15; const float inv = powf(10000.f, -(float)k / 16.f); const float a = (float)pos * inv; rope[i] = cosf(a); rope[1024 + i] = sinf(a); }
    for (int i = gt; i < NB * 2 * 3072; i += nt) { const int hh = i / 3072, e = i % 3072; KA[(size_t)hh * KVROWS * 64 + 1024 + e] = 0; VA[(size_t)hh * KVROWS * 64 + 1024 + e] = 0; }
    for (int i = gt; i < NB * 8 * 3072; i += nt) { const int hh = i / 3072, e = i % 3072; KB[(size_t)hh * KVROWS * 64 + 1024 + e] = 0; VB[(size_t)hh * KVROWS * 64 + 1024 + e] = 0; }
    for (int i = gt; i < (MPAD - NTOK) * 1024; i += nt) XN[(size_t)NTOK * 1024 + i] = 0;
    for (int i = gt; i < (MPAD - NTOK) * 1024; i += nt) Z[(size_t)NTOK * 1024 + i] = 0;
    for (int i = gt; i < 3 * (MPAD - NTOK) * 16; i += nt) { const int st = i / ((MPAD - NTOK) * 16), e = i % ((MPAD - NTOK) * 16); rowss[((size_t)st * MPAD + NTOK) * 16 + e] = (e & 15) ? 0.f : 1024.f; }
}
__global__ void __launch_bounds__(256) k_rownorm(const float* __restrict__ hreal, const float* __restrict__ hmeta, int meta_bcast, const float* __restrict__ g, bf16_t* __restrict__ XN, float* __restrict__ rowss) {
    const int lane = threadIdx.x & 63, r = blockIdx.x * 4 + (threadIdx.x >> 6);
    if (r >= NTOK) return;
    const float* src = (r < NREAL) ? hreal + (size_t)r * DM : hmeta + (size_t)(meta_bcast ? ((r - NREAL) & 15) : (r - NREAL)) * DM;
    float ss = 0.f; f32x4 v[4];
#pragma unroll
    for (int j = 0; j < 4; ++j) { v[j] = *(const f32x4*)(src + 256 * j + 4 * lane); ss += v[j].x * v[j].x + v[j].y * v[j].y + v[j].z * v[j].z + v[j].w * v[j].w; }
    ss = wave_sum(ss);
#pragma unroll
    for (int j = 0; j < 4; ++j) { const f32x4 gg = *(const f32x4*)(g + 256 * j + 4 * lane); u32x2 o; o.x = pk2(v[j].x * gg.x, v[j].y * gg.y); o.y = pk2(v[j].z * gg.z, v[j].w * gg.w); *(u32x2*)(XN + (size_t)r * DM + 256 * j + 4 * lane) = o; }
    if (lane < 16) rowss[(size_t)r * 16 + lane] = lane ? 0.f : ss;
}
__global__ void __launch_bounds__(256) k_final(float* __restrict__ out, const float* __restrict__ g) {
    const int lane = threadIdx.x & 63, r = blockIdx.x * 4 + (threadIdx.x >> 6);
    if (r >= NREAL) return;
    float* p = out + (size_t)r * DM; float ss = 0.f; f32x4 v[4];
#pragma unroll
    for (int j = 0; j < 4; ++j) { v[j] = *(const f32x4*)(p + 256 * j + 4 * lane); ss += v[j].x * v[j].x + v[j].y * v[j].y + v[j].z * v[j].z + v[j].w * v[j].w; }
    ss = wave_sum(ss); const float rstd = rsqrtf(ss * (1.f / DM) + EPS);
#pragma unroll
    for (int j = 0; j < 4; ++j) { const f32x4 gg = *(const f32x4*)(g + 256 * j + 4 * lane); *(f32x4*)(p + 256 * j + 4 * lane) = v[j] * rstd * gg; }
}

__device__ __forceinline__ void wave_gemm(const bf16_t* __restrict__ A, int lda, const bf16_t* __restrict__ Bt, int ldb, int row0, int col0, int K, f32x4 (&acc)[4]) {
    const int lane = threadIdx.x & 63;
    const bf16_t* ap = A + (size_t)(row0 + (lane & 15)) * lda + 8 * (lane >> 4);
    const bf16_t* bp = Bt + (size_t)(col0 + (lane & 15)) * ldb + 8 * (lane >> 4);
    for (int k0 = 0; k0 < K; k0 += 32) {
        const bf16x8 a = *(const bf16x8*)(ap + k0);
#pragma unroll
        for (int n = 0; n < 4; ++n) { const bf16x8 b = *(const bf16x8*)(bp + (size_t)n * 16 * ldb + k0); acc[n] = __builtin_amdgcn_mfma_f32_16x16x32_bf16(b, a, acc[n], 0, 0, 0); }
    }
}

struct InArgs { const bf16_t* XN; const bf16_t* Wt; const float* rowss; const float* qg; const float* kg; const float* rope;
                bf16_t *QA, *KA, *VA, *Z, *QB, *KB, *VB, *GA, *GB; };
__global__ void __launch_bounds__(256) k_inproj_naive(InArgs a) {
    const int lane = threadIdx.x & 63, w = threadIdx.x >> 6, fr = lane & 15, fq = lane >> 4;
    const int c0 = blockIdx.x * 64, row0 = blockIdx.y * 64 + w * 16, r = row0 + fr;
    f32x4 acc[4] = {};
    wave_gemm(a.XN, DM, a.Wt, DM, row0, c0, DM, acc);
    const RowInfo ri = row_info(r);
    float ssr = 0.f;
#pragma unroll
    for (int i = 0; i < 16; ++i) ssr += a.rowss[(size_t)r * 16 + i];
    const float rstd = rsqrtf(ssr * (1.f / DM) + EPS);
    float x[4][4];
#pragma unroll
    for (int n = 0; n < 4; ++n)
#pragma unroll
        for (int j = 0; j < 4; ++j) x[n][j] = acc[n][j] * rstd;
    const bool is_qa = c0 < C_KA, is_ka = c0 >= C_KA && c0 < C_VA;
    if (is_qa || is_ka) {
        float ss = 0.f;
#pragma unroll
        for (int n = 0; n < 4; ++n)
#pragma unroll
            for (int j = 0; j < 4; ++j) ss += x[n][j] * x[n][j];
        ss += __shfl_xor(ss, 16); ss += __shfl_xor(ss, 32);
        const float rn = rsqrtf(ss * (1.f / 64.f) + EPS);
        const float* g = is_qa ? a.qg : a.kg;
#pragma unroll
        for (int n = 0; n < 4; ++n)
#pragma unroll
            for (int j = 0; j < 4; ++j) x[n][j] = x[n][j] * rn * g[16 * n + 4 * fq + j];
        float y[4][4];
#pragma unroll
        for (int n = 0; n < 4; ++n) {
            const int pos = (n < 2) ? ri.gy : ri.gx;
#pragma unroll
            for (int j = 0; j < 4; ++j) { const float c = a.rope[pos * 16 + 4 * fq + j], s = a.rope[1024 + pos * 16 + 4 * fq + j];
                y[n][j] = (n & 1) ? (x[n][j] * c + x[n ^ 1][j] * s) : (x[n][j] * c - x[n ^ 1][j] * s); }
        }
        const float sc = is_qa ? C2 : 1.f;
#pragma unroll
        for (int n = 0; n < 4; ++n)
#pragma unroll
            for (int j = 0; j < 4; ++j) x[n][j] = y[n][j] * sc;
    }
    if (!ri.valid) return;
    bf16_t* dst; float sc = 1.f; int mode = 0;
    if (c0 < C_KA) dst = a.QA + (size_t)r * 512 + c0;
    else if (c0 < C_VA) dst = a.KA + ((size_t)(ri.b * 2 + (c0 - C_KA) / 64) * KVROWS + ri.lp) * 64;
    else if (c0 < C_ZA) dst = a.VA + ((size_t)(ri.b * 2 + (c0 - C_VA) / 64) * KVROWS + ri.lp) * 64;
    else if (c0 < C_QB) { dst = a.Z + (size_t)r * 1024 + (c0 - C_ZA); mode = 1; }
    else if (c0 < C_KB) { dst = a.QB + (size_t)r * 512 + (c0 - C_QB); sc = C2; }
    else if (c0 < C_VB) dst = a.KB + ((size_t)(ri.b * 8 + (c0 - C_KB) / 64) * KVROWS + ri.lp) * 64;
    else if (c0 < C_ZB) dst = a.VB + ((size_t)(ri.b * 8 + (c0 - C_VB) / 64) * KVROWS + ri.lp) * 64;
    else if (c0 < C_GA) { dst = a.Z + (size_t)r * 1024 + 512 + (c0 - C_ZB); mode = 1; }
    else if (c0 < C_GB) { dst = a.GA + (size_t)r * 1024 + (c0 - C_GA); mode = 2; }
    else { dst = a.GB + (size_t)r * 1024 + (c0 - C_GB); mode = 2; }
#pragma unroll
    for (int n = 0; n < 4; ++n) {
        float v[4];
#pragma unroll
        for (int j = 0; j < 4; ++j) { float t = x[n][j] * sc; if (mode == 1) t = t * sigmoidf_(t); else if (mode == 2) t = sigmoidf_(t); v[j] = t; }
        u32x2 o; o.x = pk2(v[0], v[1]); o.y = pk2(v[2], v[3]);
        *(u32x2*)(dst + 16 * n + 4 * fq) = o;
    }
}

__global__ void __launch_bounds__(256) k_mix_naive(const bf16_t* OA, const bf16_t* OB, const bf16_t* WoA, const bf16_t* WoB, const bf16_t* GA, const bf16_t* GB, bf16_t* MIX) {
    const int lane = threadIdx.x & 63, w = threadIdx.x >> 6, fr = lane & 15, fq = lane >> 4;
    const int c0 = blockIdx.x * 64, row0 = blockIdx.y * 64 + w * 16, r = row0 + fr;
    f32x4 a1[4] = {}, a2[4] = {};
    wave_gemm(OA, 1024, WoA, 512, row0, c0, 512, a1);
    wave_gemm(OB, 1024, WoB, 512, row0, c0, 512, a2);
    if (r >= NTOK) return;
#pragma unroll
    for (int n = 0; n < 4; ++n) {
        const u32x2 ga = *(const u32x2*)(GA + (size_t)r * 1024 + c0 + 16 * n + 4 * fq), gb = *(const u32x2*)(GB + (size_t)r * 1024 + c0 + 16 * n + 4 * fq);
        float v[4];
        v[0] = bf2f(ga.x & 0xffff) * a1[n][0] + bf2f(gb.x & 0xffff) * a2[n][0]; v[1] = bf2f(ga.x >> 16) * a1[n][1] + bf2f(gb.x >> 16) * a2[n][1];
        v[2] = bf2f(ga.y & 0xffff) * a1[n][2] + bf2f(gb.y & 0xffff) * a2[n][2]; v[3] = bf2f(ga.y >> 16) * a1[n][3] + bf2f(gb.y >> 16) * a2[n][3];
        u32x2 o; o.x = pk2(v[0], v[1]); o.y = pk2(v[2], v[3]);
        *(u32x2*)(MIX + (size_t)r * 1024 + c0 + 16 * n + 4 * fq) = o;
    }
}
__global__ void __launch_bounds__(256) k_out_naive(const bf16_t* MIX, const bf16_t* Wout, const float* rreal, const float* rmeta, int meta_bcast, float* oreal, float* ometa) {
    const int lane = threadIdx.x & 63, w = threadIdx.x >> 6, fr = lane & 15, fq = lane >> 4;
    const int c0 = blockIdx.x * 64, row0 = blockIdx.y * 64 + w * 16, r = row0 + fr;
    f32x4 acc[4] = {};
    wave_gemm(MIX, 1024, Wout, 1024, row0, c0, 1024, acc);
    if (r >= NTOK) return;
    const float* rs; float* od;
    if (r < NREAL) { rs = rreal + (size_t)r * DM; od = oreal + (size_t)r * DM; }
    else { rs = rmeta + (size_t)(meta_bcast ? ((r - NREAL) & 15) : (r - NREAL)) * DM; od = ometa ? ometa + (size_t)(r - NREAL) * DM : nullptr; }
    if (!od) return;
#pragma unroll
    for (int n = 0; n < 4; ++n) { const f32x4 rv = *(const f32x4*)(rs + c0 + 16 * n + 4 * fq); *(f32x4*)(od + c0 + 16 * n + 4 * fq) = rv + acc[n]; }
}

__global__ void __launch_bounds__(256) k_gqa_naive(const bf16_t* __restrict__ QA, const bf16_t* __restrict__ KA, const bf16_t* __restrict__ VA, bf16_t* ZA) {
    __shared__ __attribute__((aligned(16))) bf16_t Ks[64 * 64];
    __shared__ __attribute__((aligned(16))) bf16_t Vs[64 * 64];
    const int blk = blockIdx.x, h = blockIdx.y, b = blockIdx.z, t = threadIdx.x, kvh = h >> 2;
    int r; bool active = true;
    if (blk < 16) r = b * 4096 + blk * 256 + t; else { active = t < 16; r = NREAL + b * 16 + (active ? t : 0); }
    float q[64], o[64];
    {
        const bf16_t* qp = QA + (size_t)r * 512 + h * 64;
#pragma unroll
        for (int c = 0; c < 8; ++c) { const u32x4 v = *(const u32x4*)(qp + 8 * c);
            q[8 * c + 0] = bf2f(v.x & 0xffff); q[8 * c + 1] = bf2f(v.x >> 16); q[8 * c + 2] = bf2f(v.y & 0xffff); q[8 * c + 3] = bf2f(v.y >> 16);
            q[8 * c + 4] = bf2f(v.z & 0xffff); q[8 * c + 5] = bf2f(v.z >> 16); q[8 * c + 6] = bf2f(v.w & 0xffff); q[8 * c + 7] = bf2f(v.w >> 16); }
    }
#pragma unroll
    for (int d = 0; d < 64; ++d) o[d] = 0.f;
    float m = -INFINITY, l = 0.f;
    const bf16_t* Kb = KA + (size_t)(b * 2 + kvh) * KVROWS * 64; const bf16_t* Vb = VA + (size_t)(b * 2 + kvh) * KVROWS * 64;
    for (int tile = 0; tile < 65; ++tile) {
        __syncthreads();
#pragma unroll
        for (int i = 0; i < 2; ++i) { const int e = (t + 256 * i) * 8; *(u32x4*)(Ks + e) = *(const u32x4*)(Kb + (size_t)tile * 4096 + e); *(u32x4*)(Vs + e) = *(const u32x4*)(Vb + (size_t)tile * 4096 + e); }
        __syncthreads();
        const int nvalid = tile == 0 ? 16 : 64;
#pragma unroll 1
        for (int j = 0; j < nvalid; ++j) {
            float acc = 0.f;
#pragma unroll
            for (int c = 0; c < 8; ++c) { const u32x4 v = *(const u32x4*)(Ks + j * 64 + 8 * c);
                acc += q[8 * c + 0] * bf2f(v.x & 0xffff) + q[8 * c + 1] * bf2f(v.x >> 16) + q[8 * c + 2] * bf2f(v.y & 0xffff) + q[8 * c + 3] * bf2f(v.y >> 16)
                     + q[8 * c + 4] * bf2f(v.z & 0xffff) + q[8 * c + 5] * bf2f(v.z >> 16) + q[8 * c + 6] * bf2f(v.w & 0xffff) + q[8 * c + 7] * bf2f(v.w >> 16); }
            if (acc > m) { const float sc = exp2f(m - acc); m = acc; l *= sc;
#pragma unroll
                for (int d = 0; d < 64; ++d) o[d] *= sc; }
            const float p = exp2f(acc - m); l += p;
#pragma unroll
            for (int c = 0; c < 8; ++c) { const u32x4 v = *(const u32x4*)(Vs + j * 64 + 8 * c);
                o[8 * c + 0] += p * bf2f(v.x & 0xffff); o[8 * c + 1] += p * bf2f(v.x >> 16); o[8 * c + 2] += p * bf2f(v.y & 0xffff); o[8 * c + 3] += p * bf2f(v.y >> 16);
                o[8 * c + 4] += p * bf2f(v.z & 0xffff); o[8 * c + 5] += p * bf2f(v.z >> 16); o[8 * c + 6] += p * bf2f(v.w & 0xffff); o[8 * c + 7] += p * bf2f(v.w >> 16); }
        }
    }
    if (!active) return;
    const float inv = 1.f / l; bf16_t* zp = ZA + (size_t)r * 1024 + h * 64;
#pragma unroll
    for (int c = 0; c < 8; ++c) { const u32x4 z = *(const u32x4*)(zp + 8 * c); u32x4 w;
        w.x = pk2(o[8 * c + 0] * inv * bf2f(z.x & 0xffff), o[8 * c + 1] * inv * bf2f(z.x >> 16)); w.y = pk2(o[8 * c + 2] * inv * bf2f(z.y & 0xffff), o[8 * c + 3] * inv * bf2f(z.y >> 16));
        w.z = pk2(o[8 * c + 4] * inv * bf2f(z.z & 0xffff), o[8 * c + 5] * inv * bf2f(z.z >> 16)); w.w = pk2(o[8 * c + 6] * inv * bf2f(z.w & 0xffff), o[8 * c + 7] * inv * bf2f(z.w >> 16));
        *(u32x4*)(zp + 8 * c) = w; }
}

__global__ void __launch_bounds__(64) k_na_naive(const bf16_t* __restrict__ QB, const bf16_t* __restrict__ KB, const bf16_t* __restrict__ VB, bf16_t* ZB, const float* __restrict__ rpb) {
    const int gyb = blockIdx.x, h = blockIdx.y, b = blockIdx.z, t = threadIdx.x;
    int r, gy = 0, gx = 0; bool active = true, meta = gyb == 64;
    if (!meta) { gy = gyb; gx = t; r = b * 4096 + gy * 64 + gx; } else { active = t < 16; r = NREAL + b * 16 + (active ? t : 0); }
    const int rs = min(max(gy - 4, 0), 56), cs = min(max(gx - 8, 0), 48);
    float q[64], o[64];
    {
        const bf16_t* qp = QB + (size_t)r * 512 + h * 64;
#pragma unroll
        for (int c = 0; c < 8; ++c) { const u32x4 v = *(const u32x4*)(qp + 8 * c);
            q[8 * c + 0] = bf2f(v.x & 0xffff); q[8 * c + 1] = bf2f(v.x >> 16); q[8 * c + 2] = bf2f(v.y & 0xffff); q[8 * c + 3] = bf2f(v.y >> 16);
            q[8 * c + 4] = bf2f(v.z & 0xffff); q[8 * c + 5] = bf2f(v.z >> 16); q[8 * c + 6] = bf2f(v.w & 0xffff); q[8 * c + 7] = bf2f(v.w >> 16); }
    }
#pragma unroll
    for (int d = 0; d < 64; ++d) o[d] = 0.f;
    float m = -INFINITY, l = 0.f;
    const bf16_t* Kb = KB + (size_t)(b * 8 + h) * KVROWS * 64; const bf16_t* Vb = VB + (size_t)(b * 8 + h) * KVROWS * 64;
    const float* rp = rpb + h * 15 * 31;
#pragma unroll 1
    for (int ch = meta ? 8 : 0; ch < 9; ++ch) {
        const int kr = rs + ch; const size_t rowbase = (ch < 8) ? (size_t)(64 + kr * 64 + cs) : 0;
#pragma unroll 1
        for (int jj = 0; jj < 16; ++jj) {
            const bf16_t* kp = Kb + (rowbase + jj) * 64; float acc = 0.f;
#pragma unroll
            for (int c = 0; c < 8; ++c) { const u32x4 v = *(const u32x4*)(kp + 8 * c);
                acc += q[8 * c + 0] * bf2f(v.x & 0xffff) + q[8 * c + 1] * bf2f(v.x >> 16) + q[8 * c + 2] * bf2f(v.y & 0xffff) + q[8 * c + 3] * bf2f(v.y >> 16)
                     + q[8 * c + 4] * bf2f(v.z & 0xffff) + q[8 * c + 5] * bf2f(v.z >> 16) + q[8 * c + 6] * bf2f(v.w & 0xffff) + q[8 * c + 7] * bf2f(v.w >> 16); }
            if (ch < 8) acc += rp[(kr - gy + 7) * 31 + (cs + jj - gx + 15)] * LOG2E;
            if (acc > m) { const float sc = exp2f(m - acc); m = acc; l *= sc;
#pragma unroll
                for (int d = 0; d < 64; ++d) o[d] *= sc; }
            const float p = exp2f(acc - m); l += p; const bf16_t* vp = Vb + (rowbase + jj) * 64;
#pragma unroll
            for (int c = 0; c < 8; ++c) { const u32x4 v = *(const u32x4*)(vp + 8 * c);
                o[8 * c + 0] += p * bf2f(v.x & 0xffff); o[8 * c + 1] += p * bf2f(v.x >> 16); o[8 * c + 2] += p * bf2f(v.y & 0xffff); o[8 * c + 3] += p * bf2f(v.y >> 16);
                o[8 * c + 4] += p * bf2f(v.z & 0xffff); o[8 * c + 5] += p * bf2f(v.z >> 16); o[8 * c + 6] += p * bf2f(v.w & 0xffff); o[8 * c + 7] += p * bf2f(v.w >> 16); }
        }
    }
    if (!active) return;
    const float inv = 1.f / l; bf16_t* zp = ZB + (size_t)r * 1024 + h * 64;
#pragma unroll
    for (int c = 0; c < 8; ++c) { const u32x4 z = *(const u32x4*)(zp + 8 * c); u32x4 w;
        w.x = pk2(o[8 * c + 0] * inv * bf2f(z.x & 0xffff), o[8 * c + 1] * inv * bf2f(z.x >> 16)); w.y = pk2(o[8 * c + 2] * inv * bf2f(z.y & 0xffff), o[8 * c + 3] * inv * bf2f(z.y >> 16));
        w.z = pk2(o[8 * c + 4] * inv * bf2f(z.z & 0xffff), o[8 * c + 5] * inv * bf2f(z.z >> 16)); w.w = pk2(o[8 * c + 6] * inv * bf2f(z.w & 0xffff), o[8 * c + 7] * inv * bf2f(z.w >> 16));
        *(u32x4*)(zp + 8 * c) = w; }
}

namespace pg8 {
#define PG8_LAS __attribute__((address_space(3)))
typedef unsigned short bf16_t;
typedef short bf16x8 __attribute__((ext_vector_type(8)));
typedef float f32x4 __attribute__((ext_vector_type(4)));
typedef unsigned u32x4 __attribute__((ext_vector_type(4)));
constexpr int BM = 256, BK = 64, HALF = 128, HTB = HALF * BK * 2  , STAGE_BYTES = 8 * HTB, NXCD = 8, WGM = 8;

__host__ __device__ __forceinline__ int lds_byte(int r, int c) { const int st = (r >> 4) * 2 + (c >> 5), rr = r & 15, cc = c & 31, ob = rr * 64 + cc * 2; return st * 1024 + (ob ^ (((ob >> 9) & 1) << 5)); }
__host__ __device__ __forceinline__ void stage_rc(int b, int& R, int& C) { const int st = b / 1024, sb = b % 1024, swz = sb ^ (((sb >> 9) & 1) << 5); R = (st >> 1) * 16 + swz / 64; C = (st & 1) * 32 + (swz % 64) / 2; }
__host__ __device__ __forceinline__ int perm32(int rho) { const int n = rho >> 4, i = rho & 15; return 8 * (i >> 2) + 4 * n + (i & 3); }

struct Unit { int pm, pn; };
struct Gemm { const bf16_t* A; const bf16_t* Bt; int M, N, K; };

struct StaticOrder {
    int nM, nN, nwg, G, c;
    __host__ __device__ void init(int M, int N, int G_, int c_) { nM = M / BM; nN = N / BM; nwg = nM * nN; G = G_; c = c_; }
    __host__ __device__ bool next(int i, Unit& u) const {
        const long L = (long)i * G + c; if (L >= nwg) return false;
        int wgid = (int)L; { const int q = nwg / NXCD, r = nwg % NXCD, xcd = wgid % NXCD, off = wgid / NXCD; wgid = (xcd < r ? xcd * (q + 1) : r * (q + 1) + (xcd - r) * q) + off; }
        const int nig = WGM * nN, gid = wgid / nig, fm = gid * WGM, gsz = (nM - fm) < WGM ? (nM - fm) : WGM;
        u.pm = fm + ((wgid % nig) % gsz); u.pn = (wgid % nig) / gsz; return true;
    }
    __device__ __forceinline__ void a_ready(const Unit&) const {}
    __device__ __forceinline__ void done(const Unit&) const {}
};
__device__ __forceinline__ unsigned cvt_pk_bf16(float lo, float hi) { unsigned r; asm volatile("v_cvt_pk_bf16_f32 %0, %1, %2" : "=v"(r) : "v"(lo), "v"(hi)); return r; }

__device__ __forceinline__ float rowp_rstd(const float* rowp, int r) {
    const f32x4* p = (const f32x4*)(rowp + (size_t)r * 16); const f32x4 a = p[0], b = p[1], c = p[2], d = p[3];
    const float ss = ((a[0] + a[1]) + (a[2] + a[3])) + ((b[0] + b[1]) + (b[2] + b[3])) + ((c[0] + c[1]) + (c[2] + c[3])) + ((d[0] + d[1]) + (d[2] + d[3]));
    return rsqrtf(ss * (1.f / DM) + EPS);
}
struct EpiIn {
    static constexpr bool PERM = false, AFTER_DRAIN = false, MID = false;
    const float* rowp; const float* qg; const float* kg; const float* rope;
    bf16_t *QA, *KA, *VA, *Z, *QB, *KB, *VB, *GA, *GB;
    template <bool NR> __device__ __forceinline__ void head_rows(const f32x4 (&acc)[2][2][4][2], int rbase, int fq, const float* g, float scale, bool kv, bf16_t* dst, int nh, int head) const {
        const int fq1 = fq >> 1, fq0 = fq & 1, dl = 32 * fq1 + 8 * fq0;
        f32x4 gv[2][2];
        if (NR) {
#pragma unroll
            for (int bj = 0; bj < 2; ++bj)
#pragma unroll
                for (int n = 0; n < 2; ++n) gv[bj][n] = *(const f32x4*)(g + dl + 16 * bj + 4 * n);
        }
#pragma unroll
        for (int ai = 0; ai < 2; ++ai)
#pragma unroll
            for (int m = 0; m < 4; ++m) {
                const int r = rbase + ai * HALF + m * 16; const RowInfo ri = row_info(r);
                const float rstd = rowp_rstd(rowp, r);
                f32x4 x[2][2];
#pragma unroll
                for (int bj = 0; bj < 2; ++bj)
#pragma unroll
                    for (int n = 0; n < 2; ++n) x[bj][n] = acc[ai][bj][m][n] * rstd;
                if (NR) {
                    float ss = 0.f;
#pragma unroll
                    for (int bj = 0; bj < 2; ++bj)
#pragma unroll
                        for (int n = 0; n < 2; ++n) { const f32x4 t = x[bj][n]; ss += (t[0] * t[0] + t[1] * t[1]) + (t[2] * t[2] + t[3] * t[3]); }
                    ss += __shfl_xor(ss, 16); ss += __shfl_xor(ss, 32);
                    const float rn = rsqrtf(ss * (1.f / 64.f) + EPS);
                    const int pos = fq1 ? ri.gx : ri.gy;
#pragma unroll
                    for (int n = 0; n < 2; ++n) {
                        const f32x4 c = *(const f32x4*)(rope + pos * 16 + 8 * fq0 + 4 * n), sn = *(const f32x4*)(rope + 1024 + pos * 16 + 8 * fq0 + 4 * n);
                        const f32x4 a0 = x[0][n] * rn * gv[0][n], a1 = x[1][n] * rn * gv[1][n];
                        x[0][n] = a0 * c - a1 * sn; x[1][n] = a1 * c + a0 * sn;
                    }
                }
                if (ri.valid) {
                    bf16_t* rowp_ = kv ? dst + ((size_t)(ri.b * nh + head) * KVROWS + ri.lp) * 64 : dst + (size_t)r * 512 + head * 64;
#pragma unroll
                    for (int bj = 0; bj < 2; ++bj) { const f32x4 v0 = x[bj][0] * scale, v1 = x[bj][1] * scale; u32x4 w; w.x = cvt_pk_bf16(v0[0], v0[1]); w.y = cvt_pk_bf16(v0[2], v0[3]); w.z = cvt_pk_bf16(v1[0], v1[1]); w.w = cvt_pk_bf16(v1[2], v1[3]);
                        *(u32x4*)(rowp_ + dl + 16 * bj) = w; }
                }
                asm volatile("" ::: "memory");
            }
    }
    template <int ACT> __device__ __forceinline__ void elem_rows(const f32x4 (&acc)[2][2][4][2], int rbase, int wc, int fq, bf16_t* dst, int colbase) const {
#pragma unroll
        for (int ai = 0; ai < 2; ++ai)
#pragma unroll
            for (int m = 0; m < 4; ++m) {
                const int r = rbase + ai * HALF + m * 16; const float rstd = rowp_rstd(rowp, r);
                if (r < NTOK) {
#pragma unroll
                    for (int bj = 0; bj < 2; ++bj) { float v[8];
#pragma unroll
                        for (int n = 0; n < 2; ++n)
#pragma unroll
                            for (int j = 0; j < 4; ++j) { const float t = acc[ai][bj][m][n][j] * rstd; const float sg = __builtin_amdgcn_rcpf(1.f + __builtin_amdgcn_exp2f(-LOG2E * t)); v[4 * n + j] = ACT == 1 ? t * sg : sg; }
                        u32x4 w; w.x = cvt_pk_bf16(v[0], v[1]); w.y = cvt_pk_bf16(v[2], v[3]); w.z = cvt_pk_bf16(v[4], v[5]); w.w = cvt_pk_bf16(v[6], v[7]);
                        *(u32x4*)(dst + (size_t)r * 1024 + colbase + 128 * bj + 32 * wc + 8 * fq) = w; }
                }
                asm volatile("" ::: "memory");
            }
    }
    __device__ __forceinline__ void operator()(const f32x4 (&acc)[2][2][4][2], const Unit& u, int wr, int wc, int fr, int fq) const {
        asm volatile("" : "+v"(fr), "+v"(fq));
        const int rbase = u.pm * BM + wr * 64 + fr, t = u.pn;
        if (t < 2) head_rows<true>(acc, rbase, fq, qg, C2, false, QA, 0, 4 * t + wc);
        else if (t == 2) { if (wc < 2) head_rows<true>(acc, rbase, fq, kg, 1.f, true, KA, 2, wc); else head_rows<false>(acc, rbase, fq, nullptr, 1.f, true, VA, 2, wc - 2); }
        else if (t < 5) elem_rows<1>(acc, rbase, wc, fq, Z, (t - 3) * 256);
        else if (t < 7) head_rows<false>(acc, rbase, fq, nullptr, C2, false, QB, 0, 4 * (t - 5) + wc);
        else if (t < 9) head_rows<false>(acc, rbase, fq, nullptr, 1.f, true, KB, 8, 4 * (t - 7) + wc);
        else if (t < 11) head_rows<false>(acc, rbase, fq, nullptr, 1.f, true, VB, 8, 4 * (t - 9) + wc);
        else if (t < 13) elem_rows<1>(acc, rbase, wc, fq, Z, 512 + (t - 11) * 256);
        else if (t < 17) elem_rows<2>(acc, rbase, wc, fq, GA, (t - 13) * 256);
        else elem_rows<2>(acc, rbase, wc, fq, GB, (t - 17) * 256);
    }
};
struct EpiMix {
    static constexpr bool PERM = false, AFTER_DRAIN = false, MID = true;
    const bf16_t* GA; const bf16_t* GB; bf16_t* MIX;
    __device__ __forceinline__ void mid(f32x4 (&acc)[2][2][4][2], const Unit& u, int wr, int wc, int fr, int fq) const {
        asm volatile("" : "+v"(fr), "+v"(fq));
        const int rbase = u.pm * BM + wr * 64 + fr, cb = u.pn * BM + 32 * wc + 8 * fq;
#pragma unroll
        for (int ai = 0; ai < 2; ++ai)
#pragma unroll
            for (int m = 0; m < 4; ++m) { const size_t off = (size_t)(rbase + ai * HALF + m * 16) * 1024 + cb;
#pragma unroll
                for (int bj = 0; bj < 2; ++bj) { const u32x4 a = *(const u32x4*)(GA + off + 128 * bj), b = *(const u32x4*)(GB + off + 128 * bj);
#pragma unroll
                    for (int q = 0; q < 4; ++q) { const float a0 = bf2f(a[q] & 0xffff), a1 = bf2f(a[q] >> 16), b0 = fmaxf(bf2f(b[q] & 0xffff), 1e-30f), b1 = fmaxf(bf2f(b[q] >> 16), 1e-30f);
                        acc[ai][bj][m][q >> 1][2 * (q & 1)] *= a0 * __builtin_amdgcn_rcpf(b0); acc[ai][bj][m][q >> 1][2 * (q & 1) + 1] *= a1 * __builtin_amdgcn_rcpf(b1); } }
                asm volatile("" ::: "memory"); }
    }
    __device__ __forceinline__ void operator()(const f32x4 (&acc)[2][2][4][2], const Unit& u, int wr, int wc, int fr, int fq) const {
        asm volatile("" : "+v"(fr), "+v"(fq));
        const int rbase = u.pm * BM + wr * 64 + fr, cb = u.pn * BM + 32 * wc + 8 * fq;
#pragma unroll
        for (int ai = 0; ai < 2; ++ai)
#pragma unroll
            for (int m = 0; m < 4; ++m) { const int r = rbase + ai * HALF + m * 16; const size_t off = (size_t)r * 1024 + cb;
                if (r < NTOK) {
#pragma unroll
                    for (int bj = 0; bj < 2; ++bj) { const u32x4 b = *(const u32x4*)(GB + off + 128 * bj); u32x4 w;
#pragma unroll
                        for (int q = 0; q < 4; ++q) { const float b0 = fmaxf(bf2f(b[q] & 0xffff), 1e-30f), b1 = fmaxf(bf2f(b[q] >> 16), 1e-30f);
                            w[q] = cvt_pk_bf16(acc[ai][bj][m][q >> 1][2 * (q & 1)] * b0, acc[ai][bj][m][q >> 1][2 * (q & 1) + 1] * b1); }
                        *(u32x4*)(MIX + off + 128 * bj) = w; } }
                asm volatile("" ::: "memory"); }
    }
};
struct EpiOut {
    static constexpr bool PERM = false, AFTER_DRAIN = false, MID = false;
    const float* rreal; const float* rmeta; int meta_bcast; float* oreal; float* ometa; const float* gnext; bf16_t* XN; float* rowp;
    __device__ __forceinline__ void operator()(const f32x4 (&acc)[2][2][4][2], const Unit& u, int wr, int wc, int fr, int fq) const {
        asm volatile("" : "+v"(fr), "+v"(fq));
        const int rbase = u.pm * BM + wr * 64 + fr, cb = u.pn * BM + 32 * wc + 8 * fq;
        f32x4 gv[2][2];
        if (XN) {
#pragma unroll
            for (int bj = 0; bj < 2; ++bj)
#pragma unroll
                for (int n = 0; n < 2; ++n) gv[bj][n] = *(const f32x4*)(gnext + cb + 128 * bj + 4 * n);
        }
#pragma unroll
        for (int ai = 0; ai < 2; ++ai)
#pragma unroll
            for (int m = 0; m < 4; ++m) { const int r = rbase + ai * HALF + m * 16;
                const float* rs; float* od;
                if (r < NREAL) { rs = rreal + (size_t)r * DM; od = oreal + (size_t)r * DM; }
                else { const int q = (r < NTOK) ? r - NREAL : 0; rs = rmeta + (size_t)(meta_bcast ? (q & 15) : q) * DM; od = (ometa && r < NTOK) ? ometa + (size_t)q * DM : nullptr; }
                float ss = 0.f;
#pragma unroll
                for (int bj = 0; bj < 2; ++bj) { f32x4 h0 = *(const f32x4*)(rs + cb + 128 * bj) + acc[ai][bj][m][0], h1 = *(const f32x4*)(rs + cb + 128 * bj + 4) + acc[ai][bj][m][1];
                    ss += ((h0[0] * h0[0] + h0[1] * h0[1]) + (h0[2] * h0[2] + h0[3] * h0[3])) + ((h1[0] * h1[0] + h1[1] * h1[1]) + (h1[2] * h1[2] + h1[3] * h1[3]));
                    if (od) { *(f32x4*)(od + cb + 128 * bj) = h0; *(f32x4*)(od + cb + 128 * bj + 4) = h1; }
                    if (XN && r < NTOK) { h0 = h0 * gv[bj][0]; h1 = h1 * gv[bj][1]; u32x4 w; w.x = cvt_pk_bf16(h0[0], h0[1]); w.y = cvt_pk_bf16(h0[2], h0[3]); w.z = cvt_pk_bf16(h1[0], h1[1]); w.w = cvt_pk_bf16(h1[2], h1[3]);
                        *(u32x4*)(XN + (size_t)r * DM + cb + 128 * bj) = w; } }
                ss += __shfl_xor(ss, 16); ss += __shfl_xor(ss, 32);
                if (fq == 0 && r < NTOK) rowp[(size_t)r * 16 + 4 * u.pn + wc] = ss;
                asm volatile("" ::: "memory"); }
    }
};
template <class Epi, class Sched, bool ALIGN_EPI = false, bool SP2 = false>
__device__ __forceinline__ void gemm_phase(PG8_LAS unsigned char* lds, const Gemm g, const Sched& S, const Epi& E) {
    int tid_ = threadIdx.x; asm volatile("" : "+v"(tid_));
    const int tid = tid_, wid = __builtin_amdgcn_readfirstlane(tid >> 6), lane = tid & 63, wr = wid >> 2, wc = wid & 3, fr = lane & 15, fq = lane >> 4;
    const int K = g.K, nt = K / BK;
    unsigned voffA[2], voffB[2];
#pragma unroll
    for (int i = 0; i < 2; ++i) { int R, C; stage_rc(tid * 16 + i * 8192, R, C); const int Rb = Epi::PERM ? ((R & ~31) + perm32(R & 31)) : R;
        voffA[i] = (unsigned)(R * K + C) * 2u; voffB[i] = (unsigned)(Rb * K + C) * 2u; }
    const size_t kstep = (size_t)(BK * 2);
    const size_t hstep = (size_t)HALF * K * 2;
    const size_t tstep = 2 * hstep;
    const unsigned ldsw = (unsigned)wid * 1024u;
    const int aoff = lds_byte(wr * 64 + fr, fq * 8), boff = lds_byte(wc * 32 + fr, fq * 8);
#define PG8_SA(b, h) (((b) * 2 + (h)) * HTB)
#define PG8_SB(b, h) ((4 + (b) * 2 + (h)) * HTB)
#define PG8_STAGE(bufoff, gbase, voff) do { _Pragma("unroll") for (int _i = 0; _i < 2; ++_i) \
        __builtin_amdgcn_global_load_lds((const unsigned*)((const char*)(gbase) + (voff)[_i]), (PG8_LAS unsigned*)(lds + (bufoff) + ldsw + _i * 8192), 16, 0, 0); } while (0)
#define PG8_LDA(dst, b, h) do { _Pragma("unroll") for (int m = 0; m < 4; ++m) _Pragma("unroll") for (int k = 0; k < 2; ++k) dst[m][k] = *(const PG8_LAS bf16x8*)(lds + PG8_SA(b, h) + aoff + m * 2048 + k * 1024); } while (0)
#define PG8_LDB(dst, b, h) do { _Pragma("unroll") for (int n = 0; n < 2; ++n) _Pragma("unroll") for (int k = 0; k < 2; ++k) dst[n][k] = *(const PG8_LAS bf16x8*)(lds + PG8_SB(b, h) + boff + n * 2048 + k * 1024); } while (0)
#define PG8_MMA(ai, bj, At, Bt) do { __builtin_amdgcn_s_setprio(1); _Pragma("unroll") for (int m = 0; m < 4; ++m) _Pragma("unroll") for (int n = 0; n < 2; ++n) _Pragma("unroll") for (int k = 0; k < 2; ++k) \
        acc[ai][bj][m][n] = __builtin_amdgcn_mfma_f32_16x16x32_bf16(Bt[n][k], At[m][k], acc[ai][bj][m][n], 0, 0, 0); __builtin_amdgcn_s_setprio(0); } while (0)
#define PG8_WAIT_V(n) asm volatile("s_waitcnt vmcnt(" #n ")" ::: "memory")
#define PG8_WAIT_L(n) asm volatile("s_waitcnt lgkmcnt(" #n ")" ::: "memory")
#define PG8_BAR __builtin_amdgcn_s_barrier()
#define PG8_SCHED __builtin_amdgcn_sched_barrier(0)
    Unit cur, nxt; int ui = 0;
    (void)S.next(0, cur);
    f32x4 acc[2][2][4][2];
#pragma unroll
    for (int a = 0; a < 2; ++a)
#pragma unroll
        for (int b = 0; b < 2; ++b)
#pragma unroll
            for (int m = 0; m < 4; ++m)
#pragma unroll
                for (int n = 0; n < 2; ++n) acc[a][b][m][n] = (f32x4){0.f, 0.f, 0.f, 0.f};
    bf16x8 At[4][2], B0[2][2], B1[2][2];
    const char* cA = (const char*)g.A + (size_t)cur.pm * tstep; const char* cB = (const char*)g.Bt + (size_t)cur.pn * tstep;
    S.a_ready(cur);
    if constexpr (SP2) {
        PG8_STAGE(PG8_SB(0, 0), cB, voffB); PG8_STAGE(PG8_SB(0, 1), cB + hstep, voffB); PG8_STAGE(PG8_SA(0, 0), cA, voffA); PG8_STAGE(PG8_SA(0, 1), cA + hstep, voffA);
        if (wr == 1) PG8_BAR;
        PG8_WAIT_V(2); PG8_BAR;
        PG8_STAGE(PG8_SB(1, 0), cB + kstep, voffB); PG8_STAGE(PG8_SA(1, 0), cA + kstep, voffA); PG8_STAGE(PG8_SB(1, 1), cB + hstep + kstep, voffB);
        PG8_WAIT_V(6); PG8_BAR;
    } else {
        PG8_STAGE(PG8_SB(0, 0), cB, voffB); PG8_STAGE(PG8_SA(0, 0), cA, voffA); PG8_STAGE(PG8_SB(0, 1), cB + hstep, voffB); PG8_STAGE(PG8_SA(0, 1), cA + hstep, voffA);
        if (wr == 1) PG8_BAR;
        PG8_WAIT_V(4); PG8_BAR;
        PG8_STAGE(PG8_SB(1, 0), cB + kstep, voffB); PG8_STAGE(PG8_SA(1, 0), cA + kstep, voffA); PG8_STAGE(PG8_SB(1, 1), cB + hstep + kstep, voffB);
        PG8_WAIT_V(6); PG8_BAR;
    }
    for (;;) {
        const bool has_next = S.next(ui + 1, nxt);
        const char* nA = has_next ? (const char*)g.A + (size_t)nxt.pm * tstep : cA; const char* nB = has_next ? (const char*)g.Bt + (size_t)nxt.pn * tstep : cB;
        for (int t = 0; t < nt; t += 2) {
            const bool last = (t == nt - 2);
            const char* a1 = cA + (size_t)(t + 1) * kstep;
            const char* a2 = last ? nA : cA + (size_t)(t + 2) * kstep; const char* b2 = last ? nB : cB + (size_t)(t + 2) * kstep;
            const char* a3 = a2 + kstep; const char* b3 = b2 + kstep;
            if (last && has_next) S.a_ready(nxt);
            if constexpr (Epi::MID) { if (t == nt / 2) E.mid(acc, cur, wr, wc, fr, fq); }
            if constexpr (SP2) {
            PG8_LDB(B0, 0, 0); PG8_LDB(B1, 0, 1); PG8_SCHED; PG8_LDA(At, 0, 0); PG8_STAGE(PG8_SA(1, 1), a1 + hstep, voffA);
            PG8_WAIT_V(8); PG8_WAIT_L(0); PG8_BAR; PG8_MMA(0, 0, At, B0); PG8_MMA(0, 1, At, B1); PG8_BAR; PG8_SCHED;
            PG8_LDA(At, 0, 1); PG8_STAGE(PG8_SB(0, 0), b2, voffB); PG8_STAGE(PG8_SB(0, 1), b2 + hstep, voffB); PG8_STAGE(PG8_SA(0, 0), a2, voffA);
            PG8_WAIT_V(8); PG8_WAIT_L(0); PG8_BAR; PG8_MMA(1, 0, At, B0); PG8_MMA(1, 1, At, B1); PG8_BAR; PG8_SCHED;
            PG8_LDB(B0, 1, 0); PG8_LDB(B1, 1, 1); PG8_SCHED; PG8_LDA(At, 1, 0); PG8_STAGE(PG8_SA(0, 1), a2 + hstep, voffA);
            PG8_WAIT_V(8); PG8_WAIT_L(0); PG8_BAR; PG8_MMA(0, 0, At, B0); PG8_MMA(0, 1, At, B1); PG8_BAR; PG8_SCHED;
            PG8_LDA(At, 1, 1); PG8_STAGE(PG8_SB(1, 0), b3, voffB); PG8_STAGE(PG8_SB(1, 1), b3 + hstep, voffB); PG8_STAGE(PG8_SA(1, 0), a3, voffA);
            PG8_WAIT_V(8); PG8_WAIT_L(0); PG8_BAR; PG8_MMA(1, 0, At, B0); PG8_MMA(1, 1, At, B1); PG8_BAR; PG8_SCHED;
            } else {
            PG8_LDB(B0, 0, 0); PG8_SCHED; PG8_LDA(At, 0, 0); PG8_STAGE(PG8_SA(1, 1), a1 + hstep, voffA);
            PG8_WAIT_L(8); PG8_BAR; PG8_WAIT_L(0); PG8_MMA(0, 0, At, B0); PG8_BAR; PG8_SCHED;
            PG8_LDB(B1, 0, 1); PG8_STAGE(PG8_SB(0, 0), b2, voffB);
            PG8_BAR; PG8_WAIT_L(0); PG8_MMA(0, 1, At, B1); PG8_BAR;
            PG8_LDA(At, 0, 1); PG8_STAGE(PG8_SA(0, 0), a2, voffA);
            PG8_BAR; PG8_WAIT_L(0); PG8_MMA(1, 0, At, B0); PG8_BAR; PG8_SCHED;
            PG8_STAGE(PG8_SB(0, 1), b2 + hstep, voffB);
            PG8_WAIT_V(6); PG8_BAR; PG8_MMA(1, 1, At, B1); PG8_BAR;
            PG8_LDB(B0, 1, 0); PG8_SCHED; PG8_LDA(At, 1, 0); PG8_STAGE(PG8_SA(0, 1), a2 + hstep, voffA);
            PG8_WAIT_L(8); PG8_BAR; PG8_WAIT_L(0); PG8_MMA(0, 0, At, B0); PG8_BAR; PG8_SCHED;
            PG8_LDB(B1, 1, 1); PG8_STAGE(PG8_SB(1, 0), b3, voffB);
            PG8_BAR; PG8_WAIT_L(0); PG8_MMA(0, 1, At, B1); PG8_BAR;
            PG8_LDA(At, 1, 1); PG8_STAGE(PG8_SA(1, 0), a3, voffA);
            PG8_BAR; PG8_WAIT_L(0); PG8_MMA(1, 0, At, B0); PG8_BAR; PG8_SCHED;
            PG8_STAGE(PG8_SB(1, 1), b3 + hstep, voffB);
            PG8_WAIT_V(6); PG8_BAR; PG8_MMA(1, 1, At, B1); PG8_BAR;
            }
        }
        if constexpr (ALIGN_EPI) { if (wr == 0) PG8_BAR; }
        if constexpr (!Epi::AFTER_DRAIN) { E(acc, cur, wr, wc, fr, fq); S.done(cur); }
        if (!has_next) break;
#pragma unroll
        for (int a = 0; a < 2; ++a)
#pragma unroll
            for (int b = 0; b < 2; ++b)
#pragma unroll
                for (int m = 0; m < 4; ++m)
#pragma unroll
                    for (int n = 0; n < 2; ++n) acc[a][b][m][n] = (f32x4){0.f, 0.f, 0.f, 0.f};
        cur = nxt; cA = nA; cB = nB; ++ui;
        if constexpr (ALIGN_EPI) { if (wr == 1) PG8_BAR; }
    }
    PG8_WAIT_V(0);
    if constexpr (!ALIGN_EPI) { if (wr == 0) PG8_BAR; }
    PG8_BAR;
    if constexpr (Epi::AFTER_DRAIN) { E.fused(acc, cur, wr, wc, fr, fq, lds, wid, lane); S.done(cur); }
#undef PG8_SA
#undef PG8_SB
#undef PG8_STAGE
#undef PG8_LDA
#undef PG8_LDB
#undef PG8_MMA
#undef PG8_WAIT_V
#undef PG8_WAIT_L
#undef PG8_BAR
#undef PG8_SCHED
}
}

#include <hip/hip_bf16.h>
namespace attn_body {
using bf16=__hip_bfloat16;
using bf16x8=__attribute__((ext_vector_type(8)))short;
using s16x4=__attribute__((ext_vector_type(4)))short;
using f32x16=__attribute__((ext_vector_type(16)))float;
using u32x4=__attribute__((ext_vector_type(4)))unsigned;
constexpr int D=64,KVP=64;
constexpr int NW=8,QBLK=32,QB=QBLK*NW,KVBLK=64;
__device__ __forceinline__ int crow(int r,int hi){return (r&3)+8*(r>>2)+4*hi;}
#define SBAR() __builtin_amdgcn_sched_barrier(0)
__device__ __forceinline__ void mask_meta(f32x16&p0,f32x16&p1){
  const float NEG=-INFINITY;
  #pragma unroll
  for(int r=8;r<16;++r)p0[r]=NEG;
  #pragma unroll
  for(int r=0;r<16;++r)p1[r]=NEG;
}
__device__ __forceinline__ void na_mask(f32x16&p0,f32x16&p1,bool tvalid,int cb,const __attribute__((address_space(3))) float*bl){
  const float NEG=-INFINITY;
  if(!tvalid){
    #pragma unroll
    for(int r=0;r<16;++r){p0[r]=NEG;p1[r]=NEG;}
  }else{
    #pragma unroll
    for(int r=0;r<16;++r){const int k0=(r&3)+8*(r>>2); const float b0=bl[k0],b1=bl[k0+32];
      p0[r]=((unsigned)(k0+cb)<16u)?p0[r]+b0:NEG; p1[r]=((unsigned)(k0+32+cb)<16u)?p1[r]+b1:NEG;}
  }
}

constexpr int NSLOT=3, SLOTB=8192;
constexpr int LDS_K=0, LDS_V=NSLOT*SLOTB, LDS_WS=2*NSLOT*SLOTB, LDS_OST=LDS_WS+NW*64*4, LDS_TAB=LDS_OST+NW*4096, LDS_BYTES=LDS_TAB+2560;
constexpr float C2=0.125f*1.4426950408889634f;
__device__ __forceinline__ void glds16(const void*gsrc,unsigned lds_dst){unsigned keep;
  asm volatile("s_mov_b32 %0, m0\n\ts_mov_b32 m0, %2\n\ts_nop 0\n\tglobal_load_lds_dwordx4 %1, off\n\ts_mov_b32 m0, %0":"=&s"(keep):"v"(gsrc),"s"(lds_dst):"memory");}
__device__ __forceinline__ float max3f(float a,float b,float c){float r;asm("v_max3_f32 %0, %1, %2, %3":"=v"(r):"v"(a),"v"(b),"v"(c));return r;}
__device__ __forceinline__ float max2f(float a,float b){float r;asm("v_max_f32_e32 %0, %1, %2":"=v"(r):"v"(a),"v"(b));return r;}
__device__ __forceinline__ float fadd_s(float a,float b){float r;asm("v_add_f32_e32 %0, %1, %2":"=v"(r):"v"(a),"v"(b));return r;}
__device__ __forceinline__ float fsub_s(float a,float b){float r;asm("v_sub_f32_e32 %0, %1, %2":"=v"(r):"v"(a),"v"(b));return r;}
typedef float f32x2_t __attribute__((ext_vector_type(2))); typedef __bf16 bf16x2_t __attribute__((ext_vector_type(2)));
__device__ __forceinline__ unsigned cvtpk_s(float lo,float hi){f32x2_t v={lo,hi};bf16x2_t b=__builtin_convertvector(v,bf16x2_t);return __builtin_bit_cast(unsigned,b);}
#define WAIT_BAR(N) asm volatile("s_waitcnt vmcnt(" #N ") lgkmcnt(0)\n\ts_barrier":::"memory")

__device__ __forceinline__ void qkt(f32x16&p0,f32x16&p1,const char*Kslot,const bf16x8*qr,const f32x16&negm,int r32,int hi){
  const char*kb=Kslot+hi*1024+r32*16;
  #pragma unroll
  for(int d0=0;d0<4;++d0){
    const bf16x8 b0=*reinterpret_cast<const bf16x8*>(kb+d0*2048);
    const bf16x8 b1=*reinterpret_cast<const bf16x8*>(kb+d0*2048+512);
    if(d0==0){p0=__builtin_amdgcn_mfma_f32_32x32x16_bf16(b0,qr[0],negm,0,0,0);p1=__builtin_amdgcn_mfma_f32_32x32x16_bf16(b1,qr[0],negm,0,0,0);}
    else{p0=__builtin_amdgcn_mfma_f32_32x32x16_bf16(b0,qr[d0],p0,0,0,0);p1=__builtin_amdgcn_mfma_f32_32x32x16_bf16(b1,qr[d0],p1,0,0,0);}}
}
typedef __attribute__((address_space(3))) const char* lds_cptr;
typedef short v4i16_t __attribute__((ext_vector_type(4)));
__device__ __forceinline__ void kload8(bf16x8*kf,lds_cptr kp){
  kf[0]=*(const __attribute__((address_space(3))) bf16x8*)(kp);      kf[1]=*(const __attribute__((address_space(3))) bf16x8*)(kp+512);
  kf[2]=*(const __attribute__((address_space(3))) bf16x8*)(kp+2048); kf[3]=*(const __attribute__((address_space(3))) bf16x8*)(kp+2560);
  kf[4]=*(const __attribute__((address_space(3))) bf16x8*)(kp+4096); kf[5]=*(const __attribute__((address_space(3))) bf16x8*)(kp+4608);
  kf[6]=*(const __attribute__((address_space(3))) bf16x8*)(kp+6144); kf[7]=*(const __attribute__((address_space(3))) bf16x8*)(kp+6656);
}
__device__ __forceinline__ void kload2(bf16x8*kf,lds_cptr kp,int j){ kf[2*j]=*(const __attribute__((address_space(3))) bf16x8*)(kp+j*2048); kf[2*j+1]=*(const __attribute__((address_space(3))) bf16x8*)(kp+j*2048+512); }
__device__ __forceinline__ s16x4 vtr(lds_cptr p){ return __builtin_bit_cast(s16x4,__builtin_amdgcn_ds_read_tr16_b64_v4i16((__attribute__((address_space(3))) v4i16_t*)p)); }
__device__ __forceinline__ float rowmax(const f32x16&p0,const f32x16&p1){
  float a=max3f(p0[0],p0[1],p1[0]),b=max3f(p0[2],p0[3],p1[1]);a=max3f(a,p1[2],p1[3]);
  #pragma unroll
  for(int r=4;r<16;r+=4){a=max3f(a,p0[r],p0[r+1]);b=max3f(b,p0[r+2],p0[r+3]);a=max3f(a,p1[r],p1[r+1]);b=max3f(b,p1[r+2],p1[r+3]);}
  const float m=max2f(a,b);
  auto rr=__builtin_amdgcn_permlane32_swap(__float_as_uint(m),__float_as_uint(m),false,false);
  return max2f(__uint_as_float(rr[0]),__uint_as_float(rr[1]));
}
__device__ __forceinline__ void pv(f32x16*o,int vb,bf16x8 pa0,bf16x8 pa1,bf16x8 pa2,bf16x8 pa3){
  #pragma unroll
  for(int d0=0;d0<2;++d0){s16x4 lo[4],hi[4];
    #pragma unroll
    for(int ks=0;ks<4;++ks){
      asm volatile("ds_read_b64_tr_b16 %0,%1 offset:%c2":"=&v"(lo[ks]):"v"(vb),"i"(d0*4096+ks*1024):"memory");
      asm volatile("ds_read_b64_tr_b16 %0,%1 offset:%c2":"=&v"(hi[ks]):"v"(vb),"i"(d0*4096+ks*1024+512):"memory");}
    asm volatile("s_waitcnt lgkmcnt(0)":::"memory");SBAR();
    #define PK(k) (bf16x8){lo[k][0],lo[k][1],lo[k][2],lo[k][3],hi[k][0],hi[k][1],hi[k][2],hi[k][3]}
    o[d0]=__builtin_amdgcn_mfma_f32_32x32x16_bf16(pa0,PK(0),o[d0],0,0,0);
    o[d0]=__builtin_amdgcn_mfma_f32_32x32x16_bf16(pa1,PK(1),o[d0],0,0,0);
    o[d0]=__builtin_amdgcn_mfma_f32_32x32x16_bf16(pa2,PK(2),o[d0],0,0,0);
    o[d0]=__builtin_amdgcn_mfma_f32_32x32x16_bf16(pa3,PK(3),o[d0],0,0,0);
    #undef PK
  }
}

#ifndef ATTN_STORE16
#define ATTN_STORE16(p,v) (*(u32x4*)(p)=(v))
#endif
struct AttnPtrs { const bf16* Q; const bf16* K; const bf16* V; const bf16* Z; bf16* Zo; const float* rpb; };
template<int THRL,int KIND,int NT> __device__ __forceinline__ void attn_unit(int b,int h,int blk,bool meta,const AttnPtrs&P,char*shm){
  int tid_=threadIdx.x; asm volatile("":"+v"(tid_));
  const int tid=tid_,lane=tid&63,r32=lane&31,hi=lane>>5; const int wid=__builtin_amdgcn_readfirstlane(tid>>6);
  const int wsrc=(KIND==0&&meta)?(wid&1):wid;
  int tok0,hrow0; const int NHK=(KIND==2)?8:2;
  if(KIND==2){ tok0=b*4096+(4*blk+(wid>>1))*64+(wid&1)*32; hrow0=h; }
  else if(!meta){ tok0=b*4096+blk*256+wid*32; hrow0=h; }
  else { tok0=NREAL+b*16; hrow0=4*h+2*wsrc; }
  const bool mrows=(KIND==0&&meta);
  #define ROW_TOK(row) (mrows?tok0+((row)&15):tok0+(row))
  #define ROW_HEAD(row) (mrows?hrow0+((row)>>4):hrow0)
  const int kvh=(KIND==2)?h:(meta?h:(h>>2));
  const bf16*Kh=P.K+(size_t)(b*NHK+kvh)*KVROWS*KVP,*Vh=P.V+(size_t)(b*NHK+kvh)*KVROWS*KVP;
  const int gy0=4*blk, gmin=(KIND==2)?min(max(gy0-4,0),53):0;
  const int qrw=gy0+(wid>>1), rsw=min(max(qrw-4,0),56);
  const int qc=(wid&1)*32+r32, csl=min(max(qc-8,0),48);
  const unsigned lds0=(unsigned)(uintptr_t)shm;
  float*wsf=(float*)(shm+LDS_WS)+wid*64;
  const bf16*ksrc=Kh+(long)lane*KVP+wid*8;
  const bf16*vsrc=Vh+(long)(16*(wid&3)+(lane>>2))*KVP+(wid>>2)*32+(lane&3)*8;
  const unsigned kdst=lds0+LDS_K+wid*1024, vdst=lds0+LDS_V+wid*1024;
  #define TROW(t) ((KIND==2)?(((t)==0)?0:KVBLK*(gmin+(t))):KVBLK*(t))
  #define DMA_K(t,slot) glds16(ksrc+(long)TROW(t)*KVP,(unsigned)__builtin_amdgcn_readfirstlane(kdst+(slot)))
  #define DMA_V(t,slot) glds16(vsrc+(long)TROW(t)*KVP,(unsigned)__builtin_amdgcn_readfirstlane(vdst+(slot)))
  const int vb0=(int)(lds0+LDS_V)+((lane>>4)&1)*32+(lane&3)*8+(4*hi+((lane&15)>>2))*64;
  const char*Kbase=shm+LDS_K; bf16x8 kf[8];
  const lds_cptr shm3=(lds_cptr)shm; const lds_cptr kp0=shm3+LDS_K+hi*1024+r32*16; const lds_cptr vp0=shm3+LDS_V+((lane>>4)&1)*32+(lane&3)*8+(4*hi+((lane&15)>>2))*64;
  DMA_K(0,0);DMA_V(0,0);DMA_K(1,SLOTB);
  bf16x8 qr[4];
  #pragma unroll
  for(int d0=0;d0<4;++d0)qr[d0]=*reinterpret_cast<const bf16x8*>(P.Q+(size_t)ROW_TOK(r32)*512+ROW_HEAD(r32)*64+d0*16+hi*8);
  float mhat=0.f,l_reg=0.f;f32x16 o[2];o[0]=f32x16{};o[1]=f32x16{};f32x16 negm=f32x16{};asm volatile("":"+v"(negm));
  typedef __attribute__((address_space(3))) float lds_f32;
  lds_f32*tab=(lds_f32*)(shm+LDS_TAB);
  if(KIND==2){ for(int i=tid;i<465;i+=NW*64)tab[64+i]=P.rpb[h*465+i]*1.4426950408889634f; }
  const int cbl=4*hi-csl; const lds_f32*bl0=tab+64+15-qc+4*hi;
  #define CMASK(P0,P1,t) do{ if(KIND==2){ const int kr_=gmin+(t)-1; na_mask(P0,P1,(kr_>=rsw)&&(kr_<rsw+8),cbl,bl0+(kr_-qrw+7)*31); } }while(0)
  bool resc=false;
  #define START(P0,P1) do{ const float rm=rowmax(P0,P1); resc=false; \
    { const float dl=rm; mhat=fadd_s(mhat,dl); \
      _Pragma("unroll") for(int r=0;r<16;++r){P0[r]=fsub_s(P0[r],dl);P1[r]=fsub_s(P1[r],dl);} \
      _Pragma("unroll") for(int r=0;r<16;++r)negm[r]=-mhat; asm volatile("":"+v"(negm)); } \
    _Pragma("unroll") for(int r=0;r<16;++r)P0[r]=__builtin_amdgcn_exp2f(P0[r]); }while(0)
  #define RESC() do{ if(resc){ asm volatile("s_waitcnt lgkmcnt(0)":::"memory"); \
      _Pragma("unroll") for(int d_=0;d_<2;++d_) _Pragma("unroll") for(int r=0;r<16;++r)o[d_][r]*=wsf[crow(r,hi)]; } }while(0)
  f32x16 pA0,pA1,pB0,pB1;
  int sl_prev=0,sl_cur=0,sl_next=SLOTB;
  #define ROT() do{sl_prev=sl_cur;sl_cur=sl_next;sl_next=(sl_next==(NSLOT-1)*SLOTB)?0:sl_next+SLOTB;}while(0)
  DMA_K(2,2*SLOTB);
  WAIT_BAR(3);
  qkt(pA0,pA1,Kbase,qr,negm,r32,hi);asm volatile("s_nop 15\n\ts_nop 7":"+v"(pA0),"+v"(pA1));mask_meta(pA0,pA1);
  START(pA0,pA1);
  _Pragma("unroll") for(int r=0;r<16;++r)pA1[r]=__builtin_amdgcn_exp2f(pA1[r]);
  WAIT_BAR(0);
  DMA_K(3,0);DMA_V(1,SLOTB);
  ROT();
  kload8(kf,kp0+sl_cur);
  WAIT_BAR(2);
  s16x4 vlo[8],vhi[8]; u32x4 pw0,pw1,pw2,pw3;
  #define PKW(P,B) cvtpk_s(P[B],P[B+1])
  #define PAF(k) __builtin_bit_cast(bf16x8,pw##k)
  #define VFR(i) (bf16x8){vlo[i][0],vlo[i][1],vlo[i][2],vlo[i][3],vhi[i][0],vhi[i][1],vhi[i][2],vhi[i][3]}
  #define PIN(x) asm volatile("":"+v"(x))
  #define MX3(a,b,c) __builtin_fmaxf(__builtin_fmaxf((a),(b)),(c))
  #define GAPA(MF,A0,A1,A2,A3,W0,W1,PW) do{ MF; sacc+=A0; sacc+=A1; sacc+=A2; sacc+=A3; PIN(sacc); W0; W1; PIN(PW); SBAR(); }while(0)
  #define EX(v) __builtin_amdgcn_exp2f(v)
  #define GAPB(MF,X,B) do{ MF; X[B]=EX(X[B]); X[B+1]=EX(X[B+1]); X[B+2]=EX(X[B+2]); X[B+3]=EX(X[B+3]); PIN(X); SBAR(); }while(0)
  #define VRD(i) do{ vlo[i]=vtr(vp_+(((i)>>2)*4096+((i)&3)*1024)); vhi[i]=vtr(vp_+(((i)>>2)*4096+((i)&3)*1024+512)); }while(0)
  #define KRD(G,j) do{ if(G){ kload2(kf,kp0+sl_next,j); SBAR(); } }while(0)
  #define STEP(C0,C1,P0,P1,t,GK,GV,GL) do{ SBAR(); \
    const lds_cptr vp_=vp0+sl_prev; \
    VRD(0); SBAR(); float sacc=(P0[0]+P0[1]); \
    GAPA(C0=__builtin_amdgcn_mfma_f32_32x32x16_bf16(kf[0],qr[0],negm,0,0,0), P0[2],P0[3],P0[4],P0[5],     pw0[0]=PKW(P0,0), pw0[1]=PKW(P0,2), pw0); \
    VRD(4); SBAR(); GAPA(C1=__builtin_amdgcn_mfma_f32_32x32x16_bf16(kf[1],qr[0],negm,0,0,0), P0[6],P0[7],P0[8],P0[9],     pw0[2]=PKW(P0,4), pw0[3]=PKW(P0,6), pw0); \
    VRD(1); SBAR(); GAPA(C0=__builtin_amdgcn_mfma_f32_32x32x16_bf16(kf[2],qr[1],C0,0,0,0),   P0[10],P0[11],P0[12],P0[13], pw1[0]=PKW(P0,8), pw1[1]=PKW(P0,10), pw1); \
    VRD(5); SBAR(); GAPA(C1=__builtin_amdgcn_mfma_f32_32x32x16_bf16(kf[3],qr[1],C1,0,0,0),   P0[14],P0[15],P1[0],P1[1],   pw1[2]=PKW(P0,12),pw1[3]=PKW(P0,14), pw1); \
    VRD(2); SBAR(); GAPA(C0=__builtin_amdgcn_mfma_f32_32x32x16_bf16(kf[4],qr[2],C0,0,0,0),   P1[2],P1[3],P1[4],P1[5],     pw2[0]=PKW(P1,0), pw2[1]=PKW(P1,2), pw2); \
    VRD(6); SBAR(); GAPA(C1=__builtin_amdgcn_mfma_f32_32x32x16_bf16(kf[5],qr[2],C1,0,0,0),   P1[6],P1[7],P1[8],P1[9],     pw2[2]=PKW(P1,4), pw2[3]=PKW(P1,6), pw2); \
    VRD(3); SBAR(); GAPA(C0=__builtin_amdgcn_mfma_f32_32x32x16_bf16(kf[6],qr[3],C0,0,0,0),   P1[10],P1[11],P1[12],P1[13], pw3[0]=PKW(P1,8), pw3[1]=PKW(P1,10), pw3); \
    VRD(7); SBAR(); GAPA(C1=__builtin_amdgcn_mfma_f32_32x32x16_bf16(kf[7],qr[3],C1,0,0,0),   P1[14],P1[15],0.f,0.f,       pw3[2]=PKW(P1,12),pw3[3]=PKW(P1,14), pw3); \
    l_reg+=sacc; \
    if(GK){DMA_K((t)+3,sl_cur);} if(GV){DMA_V((t)+1,sl_next);} \
    CMASK(C0,C1,t); \
    { float a=MX3(C0[0],C0[1],C1[0]),b=MX3(C0[2],C0[3],C1[1]); a=MX3(a,C1[2],C1[3]); \
      _Pragma("unroll") for(int r=4;r<16;r+=4){a=MX3(a,C0[r],C0[r+1]);b=MX3(b,C0[r+2],C0[r+3]);a=MX3(a,C1[r],C1[r+1]);b=MX3(b,C1[r+2],C1[r+3]);} \
      float rm=__builtin_fmaxf(a,b); { auto rr=__builtin_amdgcn_permlane32_swap(__float_as_uint(rm),__float_as_uint(rm),false,false); rm=__builtin_fmaxf(__uint_as_float(rr[0]),__uint_as_float(rr[1])); } \
      resc=false; \
      if(__builtin_expect(__any(rm>(float)THRL),0)){ const float dl=__builtin_fmaxf(rm,0.f); mhat+=dl; \
        _Pragma("unroll") for(int r=0;r<16;++r){C0[r]-=dl;C1[r]-=dl;} \
        _Pragma("unroll") for(int r=0;r<16;++r)negm[r]=-mhat; asm volatile("":"+v"(negm)); \
        const float f=__builtin_amdgcn_exp2f(-dl); l_reg*=f; if(hi==0)wsf[r32]=f; resc=true; } } \
    SBAR(); \
    GAPB(o[0]=__builtin_amdgcn_mfma_f32_32x32x16_bf16(PAF(0),VFR(0),o[0],0,0,0), C0,0); \
    GAPB(o[1]=__builtin_amdgcn_mfma_f32_32x32x16_bf16(PAF(0),VFR(4),o[1],0,0,0), C0,4); \
    KRD(GL,0); GAPB(o[0]=__builtin_amdgcn_mfma_f32_32x32x16_bf16(PAF(1),VFR(1),o[0],0,0,0), C0,8); \
    KRD(GL,1); GAPB(o[1]=__builtin_amdgcn_mfma_f32_32x32x16_bf16(PAF(1),VFR(5),o[1],0,0,0), C0,12); \
    KRD(GL,2); GAPB(o[0]=__builtin_amdgcn_mfma_f32_32x32x16_bf16(PAF(2),VFR(2),o[0],0,0,0), C1,0); \
    KRD(GL,3); GAPB(o[1]=__builtin_amdgcn_mfma_f32_32x32x16_bf16(PAF(2),VFR(6),o[1],0,0,0), C1,4); \
    GAPB(o[0]=__builtin_amdgcn_mfma_f32_32x32x16_bf16(PAF(3),VFR(3),o[0],0,0,0), C1,8); \
    GAPB(o[1]=__builtin_amdgcn_mfma_f32_32x32x16_bf16(PAF(3),VFR(7),o[1],0,0,0), C1,12); \
    }while(0)
  int t=1;
  for(;t+5<NT;t+=2){
    STEP(pB0,pB1,pA0,pA1,t,true,true,true);     WAIT_BAR(2); RESC(); ROT();
    STEP(pA0,pA1,pB0,pB1,t+1,true,true,true);   WAIT_BAR(2); RESC(); ROT();
  }
  #define ENDW(tt) do{ if((tt)+3<NT){WAIT_BAR(2);} else if((tt)+2<NT){WAIT_BAR(1);} else {WAIT_BAR(0);} }while(0)
  for(;t+1<NT;t+=2){
    STEP(pB0,pB1,pA0,pA1,t,(t+3<NT),(t+1<NT),(t+1<NT));       ENDW(t);   RESC(); ROT();
    STEP(pA0,pA1,pB0,pB1,t+1,(t+4<NT),(t+2<NT),(t+2<NT));     ENDW(t+1); RESC(); ROT();
  }
  #define DRAIN(PX0,PX1,SLOT) do{ float sacc=PX0[0]+PX0[1]; _Pragma("unroll") for(int r=2;r<16;++r)sacc+=PX0[r]; _Pragma("unroll") for(int r=0;r<16;++r)sacc+=PX1[r]; l_reg+=sacc; \
    pw0=(u32x4){PKW(PX0,0),PKW(PX0,2),PKW(PX0,4),PKW(PX0,6)};pw1=(u32x4){PKW(PX0,8),PKW(PX0,10),PKW(PX0,12),PKW(PX0,14)};pw2=(u32x4){PKW(PX1,0),PKW(PX1,2),PKW(PX1,4),PKW(PX1,6)};pw3=(u32x4){PKW(PX1,8),PKW(PX1,10),PKW(PX1,12),PKW(PX1,14)}; \
    SBAR(); pv(o,vb0+(SLOT),PAF(0),PAF(1),PAF(2),PAF(3)); }while(0)
  if constexpr((NT&1)==0){ STEP(pB0,pB1,pA0,pA1,NT-1,false,false,false); RESC(); DRAIN(pB0,pB1,sl_cur); }
  else { DRAIN(pA0,pA1,sl_prev); }
  #undef DRAIN
  #undef PKW
  #undef PAF
  #undef VFR
  #undef PIN
  #undef MX3
  #undef GAPA
  #undef GAPB
  #undef EX
  #undef VRD
  #undef KRD
  #undef STEP
  #undef ENDW
  {auto rr=__builtin_amdgcn_permlane32_swap(__float_as_uint(l_reg),__float_as_uint(l_reg),false,false);l_reg=__uint_as_float(rr[0])+__uint_as_float(rr[1]);}
  if(hi==0)wsf[32+r32]=l_reg;asm volatile("s_waitcnt lgkmcnt(0)":::"memory");
  float rli[16];
  #pragma unroll
  for(int r=0;r<16;++r)rli[r]=__builtin_amdgcn_rcpf(wsf[32+crow(r,hi)]);
  { bf16*stg=(bf16*)(shm+LDS_OST)+wid*2048;
    #pragma unroll
    for(int r=0;r<16;++r){const int orow=crow(r,hi);
      #pragma unroll
      for(int d0=0;d0<2;++d0)stg[orow*64+d0*32+r32]=__float2bfloat16(o[d0][r]*rli[r]);}
    asm volatile("s_waitcnt lgkmcnt(0)":::"memory");
    const bool dostore=!(KIND==0&&meta)||wid<2;
    #pragma unroll
    for(int i=0;i<4;++i){const int row=i*8+(lane>>3),ch=lane&7; const u32x4 v=*(const u32x4*)(stg+row*64+ch*8);
      const size_t zo_=(size_t)ROW_TOK(row)*1024+ROW_HEAD(row)*64+ch*8; const u32x4 z=*(const u32x4*)(P.Z+zo_); u32x4 w;
      #pragma unroll
      for(int q=0;q<4;++q) w[q]=cvtpk_s(__uint_as_float(v[q]<<16)*__uint_as_float(z[q]<<16),__uint_as_float(v[q]&0xffff0000u)*__uint_as_float(z[q]&0xffff0000u));
      if(dostore)*(u32x4*)(P.Zo+zo_)=w; } }
  asm volatile("s_waitcnt lgkmcnt(0)\n\ts_barrier":::"memory");
  #undef DMA_K
  #undef DMA_V
  #undef TROW
  #undef ROW_TOK
  #undef ROW_HEAD
  #undef CMASK
  #undef START
  #undef RESC
  #undef ROT
}
constexpr int ATTN_LDS_BYTES=LDS_BYTES;
#undef SBAR
#undef WAIT_BAR
}

#define GAS __attribute__((address_space(1)))
#define LAS __attribute__((address_space(3)))
typedef GAS unsigned gu32;
#define RLX_AGENT __ATOMIC_RELAXED, __HIP_MEMORY_SCOPE_AGENT
#define LDS_WAIT() asm volatile("s_waitcnt lgkmcnt(0)" ::: "memory")
#define VM_WAIT() asm volatile("s_waitcnt vmcnt(0)" ::: "memory")
#define XB_TMO      128
#define XB_XCNT(j)  (256  + 64 * (j))
#define XB_XSUB(j)  (1280 + 64 * (j))
#define XB_XGEN(j)  (2304 + 64 * (j))
#define XB_TOP      3328
#define XB_TOPGEN   3392
#define XCD_BAR_WORDS 3456
#define XB_SPIN_CAP (1u << 18)

__device__ __forceinline__ unsigned xb_ld(unsigned* p)              { return __hip_atomic_load(p, __ATOMIC_RELAXED, __HIP_MEMORY_SCOPE_AGENT); }
__device__ __forceinline__ unsigned xb_add(unsigned* p, unsigned v) { return __hip_atomic_fetch_add(p, v, __ATOMIC_RELAXED, __HIP_MEMORY_SCOPE_AGENT); }
__device__ __forceinline__ unsigned xb_xcc_id() { return (unsigned)__builtin_amdgcn_s_getreg((3 << 11) | 20) & 0xFu; }
#define XB_SPIN(cond, bar) do { unsigned _sp = 0; while (cond) { __builtin_amdgcn_s_sleep(1); \
    if ((++_sp & 255u) == 0u) { if (xb_ld(&(bar)[XB_TMO])) break; if (_sp > XB_SPIN_CAP) { atomicAdd(&(bar)[XB_TMO], 1u); break; } } } } while (0)

struct XcdBarrier {
    unsigned* bar; unsigned x;
    volatile LAS unsigned* st;
};

__device__ __forceinline__ XcdBarrier xcd_barrier_post(unsigned* bar, volatile LAS unsigned* st) {
    XcdBarrier b; b.bar = bar; b.x = xb_xcc_id(); b.st = st;
    if (threadIdx.x == 0) (void)xb_add(&bar[XB_XCNT(b.x)], 1u);
    return b;
}
__device__ __forceinline__ void xcd_barrier_complete(unsigned* bar, unsigned x, unsigned& nloc, unsigned& nx) {
    const unsigned G = gridDim.x * gridDim.y * gridDim.z;
    unsigned sum, cnt, mine, sp = 0u;
    for (;;) {
        sum = 0u; cnt = 0u; mine = 0u;
#pragma unroll
        for (unsigned j = 0; j < 16; ++j) { const unsigned c = xb_ld(&bar[XB_XCNT(j)]); sum += c; cnt += (c > 0u) ? 1u : 0u; mine = (j == x) ? c : mine; }
        if (sum == G) break;
        __builtin_amdgcn_s_sleep(1);
        if ((++sp & 255u) == 0u) { if (xb_ld(&bar[XB_TMO])) break; if (sp > XB_SPIN_CAP) { atomicAdd(&bar[XB_TMO], 1u); break; } }
    }
    nloc = mine > 0u ? mine : 1u; nx = cnt > 0u ? cnt : 1u;
}

__device__ __forceinline__ void xcd_barrier(const XcdBarrier& b) {
    asm volatile("s_waitcnt vmcnt(0)" ::: "memory");
    __syncthreads();
    if (threadIdx.x == 0) {
        unsigned* bar = b.bar;
        __builtin_amdgcn_s_waitcnt(0);
        unsigned nloc = b.st[0], nx = b.st[1];
        if (nloc == 0u) { xcd_barrier_complete(bar, b.x, nloc, nx); b.st[0] = nloc; b.st[1] = nx; }
        const unsigned old = xb_add(&bar[XB_XSUB(b.x)], 1u);
        const unsigned gen = old / nloc;
        if (old + 1u == (gen + 1u) * nloc) {
            __builtin_amdgcn_fence(__ATOMIC_RELEASE, "agent");
            asm volatile("s_waitcnt vmcnt(0)" ::: "memory");
            const unsigned og = xb_add(&bar[XB_TOP], 1u);
            const unsigned tg = og / nx;
            if (og + 1u == (tg + 1u) * nx) xb_add(&bar[XB_TOPGEN], 1u);
            else XB_SPIN(xb_ld(&bar[XB_TOPGEN]) == tg, bar);
            __builtin_amdgcn_fence(__ATOMIC_ACQUIRE, "agent");
            xb_add(&bar[XB_XGEN(b.x)], 1u);
            asm volatile("s_waitcnt vmcnt(0)" ::: "memory");
        } else {
            XB_SPIN(xb_ld(&bar[XB_XGEN(b.x)]) == gen, bar);
            __builtin_amdgcn_fence(__ATOMIC_ACQUIRE, "agent");
            asm volatile("s_waitcnt vmcnt(0)" ::: "memory");
        }
    }
    __syncthreads();
}

constexpr int NWAVES = 8;
constexpr int RING_BYTES = 131072, LDSCTL_OFF = RING_BYTES, MISC_OFF = LDSCTL_OFF + 320, LDS_BYTES = 147456;
constexpr int CW_BAR = 4096;
constexpr size_t CTL_ZERO_BYTES = 1 * MiB;
constexpr int N_PHASES = 10;
static_assert(attn_body::ATTN_LDS_BYTES <= RING_BYTES, "attention scratch fits the ring region");
static_assert((CW_BAR + N_PHASES * XCD_BAR_WORDS) * 4 <= (int)CTL_ZERO_BYTES, "barrier words inside the memset block");

#ifndef PROBE_DUP
#define PROBE_DUP 0
#endif
struct MkArgs { const float* in[11]; float* out; unsigned char* ws; int ph_lo, ph_hi, li, pad; };

__device__ __forceinline__ int head_slot(int cw) { const int wc = cw >> 6, d = cw & 63; return 128 * ((d >> 4) & 1) + 32 * wc + 16 * ((d >> 2) & 1) + 8 * (d >> 5) + 4 * ((d >> 3) & 1) + (d & 3); }
__device__ __forceinline__ int elem_slot(int cw) { const int e = cw & 31; return (cw & ~31) + 16 * ((e >> 2) & 1) + 4 * (e >> 3) + (e & 3); }
__device__ __forceinline__ int in_slot(int ncol) { const int t = ncol >> 8, cw = ncol & 255; const bool head = (t < 3) || (t >= 5 && t < 11); return t * 256 + (head ? head_slot(cw) : elem_slot(cw)); }

template <bool INMAP> __device__ __forceinline__ void p0_transpose_item(const float* W, int K, int N, bf16_t* WT, int ldk, int koff, LAS float* scr, int item, int lane) {
    const int nblk = N / 32, kb = item / nblk, nb = item % nblk, k0 = 64 * kb, n0 = 32 * nb;
#pragma unroll 8
    for (int i = 0; i < 32; ++i) { const int kk = 2 * i + (lane >> 5); scr[kk * 33 + (lane & 31)] = W[(size_t)(k0 + kk) * N + n0 + (lane & 31)]; }
    LDS_WAIT(); asm volatile("" ::: "memory");
    const int c = lane & 7;
#pragma unroll
    for (int j = 0; j < 4; ++j) { const int n = (lane >> 3) + 8 * j; const LAS float* s = scr + (8 * c) * 33 + n;
        u32x4 o; o.x = pk2(s[0 * 33], s[1 * 33]); o.y = pk2(s[2 * 33], s[3 * 33]); o.z = pk2(s[4 * 33], s[5 * 33]); o.w = pk2(s[6 * 33], s[7 * 33]);
        const int nc = n0 + n, row = INMAP ? in_slot(nc) : ((nc & ~255) + elem_slot(nc & 255));
        *(u32x4*)(WT + (size_t)row * ldk + koff + k0 + 8 * c) = o; }
    LDS_WAIT(); asm volatile("" ::: "memory");
}

struct Ptrs {
    const float *x, *meta, *norm_g, *w_in, *qng, *kng, *rpb, *w_oa, *w_ob, *w_out, *fin_g; float* out;
    float *rope, *HM, *rowp; bf16_t *WinP, *WoC, *WoutP, *XN, *QA, *QB, *MIX, *Z, *KA, *VA, *KB, *VB, *GA, *GB;
};
__device__ __forceinline__ void p0_prologue(const Ptrs& P, LAS unsigned char* lds, int vcu, int G, int wave, int lane) {
    LAS float* scr = (LAS float*)(lds + wave * 16384);
    const int gw = vcu * NWAVES + wave, NGW = G * NWAVES;
    constexpr int I_IN = (DM / 64) * (INC / 32), I_O = (512 / 64) * (DM / 32), I_OUT = (DM / 64) * (DM / 32), I_L = I_IN + 2 * I_O + I_OUT;
    for (int it = gw; it < 2 * I_L; it += NGW) {
        const int l = it / I_L; int r = it % I_L;
        if (r < I_IN) { p0_transpose_item<true>(P.w_in + (size_t)l * DM * INC, DM, INC, P.WinP + (size_t)l * INC * DM, DM, 0, scr, r, lane); continue; } r -= I_IN;
        if (r < I_O) { p0_transpose_item<false>(P.w_oa + (size_t)l * 512 * DM, 512, DM, P.WoC + (size_t)l * DM * DM, DM, 0, scr, r, lane); continue; } r -= I_O;
        if (r < I_O) { p0_transpose_item<false>(P.w_ob + (size_t)l * 512 * DM, 512, DM, P.WoC + (size_t)l * DM * DM, DM, 512, scr, r, lane); continue; } r -= I_O;
        p0_transpose_item<false>(P.w_out + (size_t)l * DM * DM, DM, DM, P.WoutP + (size_t)l * DM * DM, DM, 0, scr, r, lane);
    }
    for (int r = gw; r < NTOK; r += NGW) {
        const float* src = (r < NREAL) ? P.x + (size_t)r * DM : P.meta + (size_t)((r - NREAL) & 15) * DM;
        float ss = 0.f; f32x4 v[4];
#pragma unroll
        for (int j = 0; j < 4; ++j) { v[j] = *(const f32x4*)(src + 256 * j + 4 * lane); ss += (v[j].x * v[j].x + v[j].y * v[j].y) + (v[j].z * v[j].z + v[j].w * v[j].w); }
        ss = wave_sum(ss);
#pragma unroll
        for (int j = 0; j < 4; ++j) { const f32x4 gg = *(const f32x4*)(P.norm_g + 256 * j + 4 * lane); u32x2 o; o.x = pk2(v[j].x * gg.x, v[j].y * gg.y); o.y = pk2(v[j].z * gg.z, v[j].w * gg.w); *(u32x2*)(P.XN + (size_t)r * DM + 256 * j + 4 * lane) = o; }
        if (lane < 16) P.rowp[(size_t)r * 16 + lane] = lane ? 0.f : ss;
    }
    const int gt = gw * 64 + lane, nt = NGW * 64;
    for (int i = gt; i < 64 * 16; i += nt) { const int pos = i >> 4, k = i & 15; const float inv = powf(10000.f, -(float)k / 16.f); const float a = (float)pos * inv; P.rope[i] = cosf(a); P.rope[1024 + i] = sinf(a); }
    for (int i = gt; i < NB * 2 * 3072; i += nt) { const int hh = i / 3072, e = i % 3072; P.KA[(size_t)hh * KVROWS * 64 + 1024 + e] = 0; P.VA[(size_t)hh * KVROWS * 64 + 1024 + e] = 0; }
    for (int i = gt; i < NB * 8 * 3072; i += nt) { const int hh = i / 3072, e = i % 3072; P.KB[(size_t)hh * KVROWS * 64 + 1024 + e] = 0; P.VB[(size_t)hh * KVROWS * 64 + 1024 + e] = 0; }
    for (int i = gt; i < (MPAD - NTOK) * 1024; i += nt) { P.XN[(size_t)NTOK * 1024 + i] = 0; P.Z[(size_t)NTOK * 1024 + i] = 0; }
    for (int i = gt; i < 3 * (MPAD - NTOK) * 16; i += nt) { const int st = i / ((MPAD - NTOK) * 16), e = i % ((MPAD - NTOK) * 16); P.rowp[((size_t)st * MPAD + NTOK) * 16 + e] = (e & 15) ? 0.f : 1024.f; }
}

__device__ __forceinline__ void na_meta_wave(int b, int h, const Ptrs& P, int lane) {
    const int q = lane & 15, dq = lane >> 4, tok = NREAL + b * 16 + q;
    float qv[16], o[16], s[16];
    { const bf16_t* qp = P.QB + (size_t)tok * 512 + h * 64 + 16 * dq;
#pragma unroll
      for (int c = 0; c < 2; ++c) { const u32x4 v = *(const u32x4*)(qp + 8 * c);
#pragma unroll
        for (int e = 0; e < 4; ++e) { qv[8 * c + 2 * e] = bf2f(v[e] & 0xffff); qv[8 * c + 2 * e + 1] = bf2f(v[e] >> 16); } } }
    const bf16_t* Kh = P.KB + (size_t)(b * 8 + h) * KVROWS * 64 + 16 * dq; const bf16_t* Vh = P.VB + (size_t)(b * 8 + h) * KVROWS * 64 + 16 * dq;
    float mx = -INFINITY;
#pragma unroll
    for (int j = 0; j < 16; ++j) { float acc = 0.f;
#pragma unroll
        for (int c = 0; c < 2; ++c) { const u32x4 v = *(const u32x4*)(Kh + j * 64 + 8 * c);
#pragma unroll
            for (int e = 0; e < 4; ++e) acc += qv[8 * c + 2 * e] * bf2f(v[e] & 0xffff) + qv[8 * c + 2 * e + 1] * bf2f(v[e] >> 16); }
        acc += __shfl_xor(acc, 16); acc += __shfl_xor(acc, 32); s[j] = acc; mx = fmaxf(mx, acc); }
    float l = 0.f;
#pragma unroll
    for (int i = 0; i < 16; ++i) o[i] = 0.f;
#pragma unroll
    for (int j = 0; j < 16; ++j) { const float p = exp2f(s[j] - mx); l += p;
#pragma unroll
        for (int c = 0; c < 2; ++c) { const u32x4 v = *(const u32x4*)(Vh + j * 64 + 8 * c);
#pragma unroll
            for (int e = 0; e < 4; ++e) { o[8 * c + 2 * e] += p * bf2f(v[e] & 0xffff); o[8 * c + 2 * e + 1] += p * bf2f(v[e] >> 16); } } }
    const float inv = 1.f / l; bf16_t* zp = P.Z + (size_t)tok * 1024 + 512 + h * 64 + 16 * dq;
#pragma unroll
    for (int c = 0; c < 2; ++c) { const u32x4 z = *(const u32x4*)(zp + 8 * c); u32x4 w;
#pragma unroll
        for (int e = 0; e < 4; ++e) w[e] = pk2(o[8 * c + 2 * e] * inv * bf2f(z[e] & 0xffff), o[8 * c + 2 * e + 1] * inv * bf2f(z[e] >> 16));
        *(u32x4*)(zp + 8 * c) = w; }
}

__device__ __forceinline__ f32x4 skinny_acc(const bf16_t* __restrict__ A, const bf16_t* __restrict__ B, int K) {
    f32x4 acc = {0.f, 0.f, 0.f, 0.f};
#pragma unroll 1
    for (int k0 = 0; k0 < K; k0 += 256) {
        bf16x8 a[8], b[8];
#pragma unroll
        for (int i = 0; i < 8; ++i) { a[i] = *(const bf16x8*)(A + k0 + 32 * i); b[i] = *(const bf16x8*)(B + k0 + 32 * i); }
#pragma unroll
        for (int i = 0; i < 8; ++i) acc = __builtin_amdgcn_mfma_f32_16x16x32_bf16(b[i], a[i], acc, 0, 0, 0);
    }
    return acc;
}
__device__ __forceinline__ void skinny_mix(const Ptrs& P, int vcu, int wave, int lane) {
    if (vcu >= 128 || wave >= 4) return;
    const int fr = lane & 15, fq = lane >> 4, r = NREAL + 16 * (vcu >> 4) + fr, c0 = 64 * (vcu & 15) + 16 * wave, c = c0 + fr;
    const bf16_t* Ar = P.Z + (size_t)r * 1024 + 8 * fq; const bf16_t* Br = P.WoC + (size_t)((c & ~255) + elem_slot(c & 255)) * 1024 + 8 * fq;
    const f32x4 a1 = skinny_acc(Ar, Br, 512), a2 = skinny_acc(Ar + 512, Br + 512, 512);
    const size_t off = (size_t)r * 1024 + c0 + 4 * fq;
    const u32x2 ga = *(const u32x2*)(P.GA + off), gb = *(const u32x2*)(P.GB + off);
    u32x2 o; o.x = pk2(bf2f(ga.x & 0xffff) * a1[0] + bf2f(gb.x & 0xffff) * a2[0], bf2f(ga.x >> 16) * a1[1] + bf2f(gb.x >> 16) * a2[1]);
    o.y = pk2(bf2f(ga.y & 0xffff) * a1[2] + bf2f(gb.y & 0xffff) * a2[2], bf2f(ga.y >> 16) * a1[3] + bf2f(gb.y >> 16) * a2[3]);
    *(u32x2*)(P.MIX + off) = o;
}
__device__ __forceinline__ void skinny_out(const Ptrs& P, int vcu, int wave, int lane, LAS float* part) {
    if (vcu < 128 && wave < 4) {
        const int fr = lane & 15, fq = lane >> 4, r = NREAL + 16 * (vcu >> 4) + fr, c0 = 64 * (vcu & 15) + 16 * wave, c = c0 + fr, cc = c0 + 4 * fq;
        const bf16_t* Ar = P.MIX + (size_t)r * 1024 + 8 * fq; const bf16_t* Br = P.WoutP + (size_t)((c & ~255) + elem_slot(c & 255)) * 1024 + 8 * fq;
        const f32x4 acc = skinny_acc(Ar, Br, 1024);
        const f32x4 h = *(const f32x4*)(P.meta + (size_t)((r - NREAL) & 15) * DM + cc) + acc;
        *(f32x4*)(P.HM + (size_t)(r - NREAL) * DM + cc) = h;
        const f32x4 g = *(const f32x4*)(P.norm_g + DM + cc);
        u32x2 o; o.x = pk2(h[0] * g[0], h[1] * g[1]); o.y = pk2(h[2] * g[2], h[3] * g[3]); *(u32x2*)(P.XN + (size_t)r * DM + cc) = o;
        float ss = (h[0] * h[0] + h[1] * h[1]) + (h[2] * h[2] + h[3] * h[3]); ss += __shfl_xor(ss, 16); ss += __shfl_xor(ss, 32);
        if (fq == 0) part[wave * 16 + fr] = ss;
    }
    __syncthreads();
    if (vcu < 128 && wave == 0 && lane < 16) P.rowp[((size_t)MPAD + NREAL + 16 * (vcu >> 4) + lane) * 16 + (vcu & 15)] = (part[lane] + part[16 + lane]) + (part[32 + lane] + part[48 + lane]);
    __syncthreads();
}

typedef const __attribute__((address_space(4))) MkArgs* KArgP;
__device__ __forceinline__ KArgP kargs() { KArgP p = (KArgP)__builtin_amdgcn_kernarg_segment_ptr(); asm volatile("" : "+s"(p)); return p; }
__device__ __forceinline__ Ptrs make_ptrs() {
    KArgP a = kargs(); Ptrs P; unsigned char* ws = a->ws;
    P.x = a->in[0]; P.meta = a->in[1]; P.norm_g = a->in[2]; P.w_in = a->in[3]; P.qng = a->in[4]; P.kng = a->in[5]; P.rpb = a->in[6];
    P.w_oa = a->in[7]; P.w_ob = a->in[8]; P.w_out = a->in[9]; P.fin_g = a->in[10]; P.out = a->out;
    P.rope = (float*)(ws + WS_ROPE); P.HM = (float*)(ws + WS_HM); P.rowp = (float*)(ws + WS_ROWP);
    P.WinP = (bf16_t*)(ws + WS_WIN_P); P.WoC = (bf16_t*)(ws + WS_WOC); P.WoutP = (bf16_t*)(ws + WS_WOUT_P); P.XN = (bf16_t*)(ws + WS_XN);
    P.QA = (bf16_t*)(ws + WS_QA); P.QB = (bf16_t*)(ws + WS_QB); P.MIX = (bf16_t*)(ws + WS_MIX); P.Z = (bf16_t*)(ws + WS_Z);
    P.KA = (bf16_t*)(ws + WS_KA); P.VA = (bf16_t*)(ws + WS_VA); P.KB = (bf16_t*)(ws + WS_KB); P.VB = (bf16_t*)(ws + WS_VB); P.GA = (bf16_t*)(ws + WS_GA); P.GB = (bf16_t*)(ws + WS_GB);
    return P;
}
__global__ void __launch_bounds__(NWAVES * 64, 2) mk_fwd(MkArgs args) {
    extern __shared__ __attribute__((aligned(16))) unsigned char lds[];
    LAS unsigned char* L = (LAS unsigned char*)lds;
    volatile LAS unsigned* MISC = (volatile LAS unsigned*)(L + MISC_OFF);
    const int tid = threadIdx.x;
    const int G = gridDim.x; const int bx = blockIdx.x;
    const int vcu_ = (G % 8 == 0) ? (bx % 8) * (G / 8) + bx / 8 : bx;
#define VCU vcu_
#define WAVE (__builtin_amdgcn_readfirstlane((int)threadIdx.x >> 6))
#define LANE ([]() __attribute__((always_inline)) { int t_ = threadIdx.x; asm volatile("" : "+v"(t_)); return t_ & 63; }())
    for (int u = tid; u < (LDS_BYTES - LDSCTL_OFF) / 4; u += NWAVES * 64) ((LAS unsigned*)(L + LDSCTL_OFF))[u] = 0u;
    __syncthreads();
    XcdBarrier bar = xcd_barrier_post((unsigned*)(args.ws + WS_CTL) + CW_BAR + args.li * XCD_BAR_WORDS, MISC + 8);
    const int lo = args.ph_lo, hi = args.ph_hi;
#define IN(k) (lo <= (k) && (k) < hi)
#define SEAM(k) do { if (IN(k) && IN((k) + 1)) xcd_barrier(bar); } while (0)

    if (IN(0)) { const Ptrs P = make_ptrs(); p0_prologue(P, L, VCU, G, WAVE, LANE); SEAM(0); }

#pragma unroll 1
    for (int l = 0; l < 2; ++l) {
        const int pb = 1 + 4 * l;
        if (IN(pb)) {
            const Ptrs P = make_ptrs();
            pg8::Gemm g{P.XN, P.WinP + (size_t)l * INC * DM, MPAD, INC, DM}; pg8::StaticOrder S; S.init(MPAD, INC, G, bx);
            pg8::EpiIn E{P.rowp + (size_t)l * MPAD * 16, P.qng + l * 64, P.kng + l * 64, P.rope, P.QA, P.KA, P.VA, P.Z, P.QB, P.KB, P.VB, P.GA, P.GB};
#pragma unroll 1
            for (int rep = ((PROBE_DUP & 1) && l == 0) ? 0 : 1; rep < 2; ++rep) { if (rep == 0) { int z_ = 0; asm volatile("" : "+s"(z_)); } pg8::gemm_phase<pg8::EpiIn, pg8::StaticOrder, true, true>(L, g, S, E); if (rep == 0) xcd_barrier(bar); }
            SEAM(pb);
        }
        if (IN(pb + 1)) {
            { const Ptrs P = make_ptrs(); const int vcu = VCU;
              attn_body::AttnPtrs PA{(const attn_body::bf16*)P.QA, (const attn_body::bf16*)P.KA, (const attn_body::bf16*)P.VA, (const attn_body::bf16*)P.Z, (attn_body::bf16*)P.Z, nullptr};
              const int nun = (l == 0 && vcu < 16) ? 5 : 4;
              const int ndup = ((PROBE_DUP & 2) && l == 1) ? 4 : 0;
#pragma unroll 1
              for (int ii = 0; ii < nun + ndup; ++ii) {
                const int i = ii < ndup ? ii : ii - ndup; PA.Zo = (attn_body::bf16*)(ii < ndup ? P.XN : P.Z);
                const bool meta = i == 4; const int pair = meta ? vcu : (vcu >> 4), qb = vcu & 15;
                attn_body::attn_unit<8, 0, 65>(pair >> 1, meta ? (pair & 1) : 4 * (pair & 1) + i, qb, meta, PA, (char*)lds);
              } }
            { const Ptrs P = make_ptrs(); const int vcu = VCU;
              attn_body::AttnPtrs PB{(const attn_body::bf16*)P.QB, (const attn_body::bf16*)P.KB, (const attn_body::bf16*)P.VB, (const attn_body::bf16*)(P.Z + 512), (attn_body::bf16*)(P.Z + 512), P.rpb + (size_t)l * 8 * 465};
              const int ndupb = ((PROBE_DUP & 4) && l == 1) ? 4 : 0;
              const int nb = (l == 0) ? (vcu < 16 ? 2 : (vcu < 48 ? 5 : 4)) : 4;
#pragma unroll 1
              for (int ii = 0; ii < nb + ndupb; ++ii) {
                const int i2 = ii < ndupb ? ii : ii - ndupb; PB.Zo = (attn_body::bf16*)(ii < ndupb ? P.XN + 512 : P.Z + 512);
                const int u = (i2 < 4) ? vcu + 256 * i2 : ((vcu - 16) >> 1) + 256 * (2 + ((vcu - 16) & 1));
                const int bh = (u & 255) >> 2, blk = 4 * (u & 3) + (u >> 8);
                attn_body::attn_unit<8, 2, 12>(bh >> 3, bh & 7, blk, false, PB, (char*)lds);
              }
              if (l == 0) { const int ln = LANE; for (int u = vcu * NWAVES + WAVE; u < 64; u += G * NWAVES) na_meta_wave(u >> 3, u & 7, P, ln); } }
            SEAM(pb + 1);
        }
        if (IN(pb + 2)) {
            const Ptrs P = make_ptrs();
            if (l == 0) skinny_mix(P, VCU, WAVE, LANE);
            pg8::Gemm g{P.Z, P.WoC + (size_t)l * DM * DM, NREAL, DM, DM}; pg8::StaticOrder S; S.init(NREAL, DM, G, bx);
            pg8::EpiMix E{P.GA, P.GB, P.MIX};
#pragma unroll 1
            for (int rep = ((PROBE_DUP & 8) && l == 0) ? 0 : 1; rep < 2; ++rep) { if (rep == 0) { int z_ = 0; asm volatile("" : "+s"(z_)); } pg8::gemm_phase<pg8::EpiMix, pg8::StaticOrder, true, true>(L, g, S, E); if (rep == 0) xcd_barrier(bar); }
            SEAM(pb + 2);
        }
        if (IN(pb + 3)) {
            const Ptrs P = make_ptrs();
            if (l == 0) skinny_out(P, VCU, WAVE, LANE, (LAS float*)(L + LDSCTL_OFF));
            pg8::Gemm g{P.MIX, P.WoutP + (size_t)l * DM * DM, NREAL, DM, DM}; pg8::StaticOrder S; S.init(NREAL, DM, G, bx);
            pg8::EpiOut E;
            if (l == 0) E = pg8::EpiOut{P.x, P.meta, 1, P.out, P.HM, P.norm_g + DM, P.XN, P.rowp + (size_t)1 * MPAD * 16};
            else E = pg8::EpiOut{P.out, P.HM, 0, P.out, nullptr, nullptr, nullptr, P.rowp + (size_t)2 * MPAD * 16};
#pragma unroll 1
            for (int rep = ((PROBE_DUP & 8) && l == 0) ? 0 : 1; rep < 2; ++rep) { if (rep == 0) { int z_ = 0; asm volatile("" : "+s"(z_)); } pg8::gemm_phase<pg8::EpiOut, pg8::StaticOrder, true, true>(L, g, S, E); if (rep == 0) xcd_barrier(bar); }
            SEAM(pb + 3);
        }
    }
    if (IN(9)) {
        const Ptrs P = make_ptrs(); const int lane = LANE;
        const float* rp = P.rowp + (size_t)2 * MPAD * 16;
        for (int r = VCU * NWAVES + WAVE; r < NREAL; r += G * NWAVES) {
            const float rstd = pg8::rowp_rstd(rp, r); float* p = P.out + (size_t)r * DM;
#pragma unroll
            for (int j = 0; j < 4; ++j) { const f32x4 v = *(const f32x4*)(p + 256 * j + 4 * lane), gg = *(const f32x4*)(P.fin_g + 256 * j + 4 * lane); *(f32x4*)(p + 256 * j + 4 * lane) = v * rstd * gg; }
        }
    }
#undef IN
#undef SEAM
#undef VCU
#undef WAVE
#undef LANE
}

#ifndef OPT_MASK
#define OPT_MASK 0x3FF
#endif
#ifndef FORCE_HYBRID
#define FORCE_HYBRID 0
#endif
extern "C" void kernel_launch(void* const* d_in, const int* in_sizes, int n_in, void* d_out, int out_size, void* d_ws, size_t ws_size, hipStream_t stream) {
    static int grid = 0;
    if (grid == 0) {
        if (n_in != 11 || ws_size < WS_END || out_size != NREAL * DM) { fprintf(stderr, "kernel_launch: unexpected shapes (n_in %d, ws %zu, out %d)\n", n_in, ws_size, out_size); grid = -1; return; }
        int dev = 0, cus = 0, per_cu = 0;
        if (hipGetDevice(&dev) != hipSuccess || hipDeviceGetAttribute(&cus, hipDeviceAttributeMultiprocessorCount, dev) != hipSuccess) { grid = -1; return; }
        if (hipFuncSetAttribute((const void*)mk_fwd, hipFuncAttributeMaxDynamicSharedMemorySize, LDS_BYTES) != hipSuccess) { fprintf(stderr, "kernel_launch: hipFuncSetAttribute failed\n"); grid = -1; return; }
        if (hipOccupancyMaxActiveBlocksPerMultiprocessor(&per_cu, (const void*)mk_fwd, NWAVES * 64, LDS_BYTES) != hipSuccess || per_cu < 1) { fprintf(stderr, "kernel_launch: occupancy query says %d blocks per CU\n", per_cu); (void)hipGetLastError(); }
        if (cus < 256) { fprintf(stderr, "kernel_launch: %d CUs, need 256\n", cus); grid = -1; return; }
        grid = 256;
    }
    if (grid < 0) return;
    const float* x = (const float*)d_in[0]; const float* meta = (const float*)d_in[1]; const float* norm_g = (const float*)d_in[2]; const float* w_in = (const float*)d_in[3];
    const float* qng = (const float*)d_in[4]; const float* kng = (const float*)d_in[5]; const float* rpb = (const float*)d_in[6];
    const float* w_oa = (const float*)d_in[7]; const float* w_ob = (const float*)d_in[8]; const float* w_out = (const float*)d_in[9]; const float* fin_g = (const float*)d_in[10];
    unsigned char* ws = (unsigned char*)d_ws; float* out = (float*)d_out;
    (void)hipMemsetAsync(ws + WS_CTL, 0, CTL_ZERO_BYTES, stream);
    MkArgs a{};
    for (int i = 0; i < 11; ++i) a.in[i] = (const float*)d_in[i];
    a.out = out; a.ws = ws;
    if (OPT_MASK == 0x3FF && !FORCE_HYBRID) {
        a.ph_lo = 0; a.ph_hi = N_PHASES; a.li = 0;
        hipLaunchKernelGGL(mk_fwd, dim3(grid), dim3(NWAVES * 64), LDS_BYTES, stream, a);
        return;
    }
    float* rowp = (float*)(ws + WS_ROWP); float* rope = (float*)(ws + WS_ROPE); float* HM = (float*)(ws + WS_HM);
    bf16_t* WinN = (bf16_t*)(ws + WS_WIN_N); bf16_t* WoA = (bf16_t*)(ws + WS_WOA); bf16_t* WoB = (bf16_t*)(ws + WS_WOB); bf16_t* Wout = (bf16_t*)(ws + WS_WOUT);
    bf16_t* XN = (bf16_t*)(ws + WS_XN); bf16_t* QA = (bf16_t*)(ws + WS_QA); bf16_t* QB = (bf16_t*)(ws + WS_QB); bf16_t* MIX = (bf16_t*)(ws + WS_MIX); bf16_t* Z = (bf16_t*)(ws + WS_Z);
    bf16_t* KA = (bf16_t*)(ws + WS_KA); bf16_t* VA = (bf16_t*)(ws + WS_VA); bf16_t* KB = (bf16_t*)(ws + WS_KB); bf16_t* VB = (bf16_t*)(ws + WS_VB); bf16_t* GA = (bf16_t*)(ws + WS_GA); bf16_t* GB = (bf16_t*)(ws + WS_GB);
    auto mk = [&](int p) { a.ph_lo = p; a.ph_hi = p + 1; a.li = p; hipLaunchKernelGGL(mk_fwd, dim3(grid), dim3(NWAVES * 64), LDS_BYTES, stream, a); };
    for (int l = 0; l < 2; ++l) {
        k_transpose<<<dim3(INC / 32, DM / 32), 256, 0, stream>>>(w_in + (size_t)l * DM * INC, WinN + (size_t)l * INC * DM, DM, INC);
        k_transpose<<<dim3(DM / 32, 512 / 32), 256, 0, stream>>>(w_oa + (size_t)l * 512 * DM, WoA + (size_t)l * DM * 512, 512, DM);
        k_transpose<<<dim3(DM / 32, 512 / 32), 256, 0, stream>>>(w_ob + (size_t)l * 512 * DM, WoB + (size_t)l * DM * 512, 512, DM);
        k_transpose<<<dim3(DM / 32, DM / 32), 256, 0, stream>>>(w_out + (size_t)l * DM * DM, Wout + (size_t)l * DM * DM, DM, DM);
    }
    if (OPT_MASK != 0) mk(0);
    if (!(OPT_MASK & 1)) { k_misc<<<256, 256, 0, stream>>>(rope, KA, VA, KB, VB, XN, Z, rowp); k_rownorm<<<NTOK / 4, 256, 0, stream>>>(x, meta, 1, norm_g, XN, rowp); }
    for (int l = 0; l < 2; ++l) {
        const int pb = 1 + 4 * l;
        if ((OPT_MASK >> pb) & 1) mk(pb);
        else { InArgs ia{XN, WinN + (size_t)l * INC * DM, rowp + (size_t)l * MPAD * 16, qng + l * 64, kng + l * 64, rope, QA, KA, VA, Z, QB, KB, VB, GA, GB}; k_inproj_naive<<<dim3(INC / 64, MPAD / 64), 256, 0, stream>>>(ia); }
        if ((OPT_MASK >> (pb + 1)) & 1) mk(pb + 1);
        else { k_gqa_naive<<<dim3(17, 8, NB), 256, 0, stream>>>(QA, KA, VA, Z); k_na_naive<<<dim3(65, 8, NB), 64, 0, stream>>>(QB, KB, VB, Z + 512, rpb + (size_t)l * 8 * 15 * 31); }
        if ((OPT_MASK >> (pb + 2)) & 1) mk(pb + 2);
        else k_mix_naive<<<dim3(DM / 64, MPAD / 64), 256, 0, stream>>>(Z, Z + 512, WoA + (size_t)l * DM * 512, WoB + (size_t)l * DM * 512, GA, GB, MIX);
        if ((OPT_MASK >> (pb + 3)) & 1) mk(pb + 3);
        else if (l == 0) { k_out_naive<<<dim3(DM / 64, MPAD / 64), 256, 0, stream>>>(MIX, Wout, x, meta, 1, out, HM); k_rownorm<<<NTOK / 4, 256, 0, stream>>>(out, HM, 0, norm_g + DM, XN, rowp + (size_t)MPAD * 16); }
        else { k_out_naive<<<dim3(DM / 64, MPAD / 64), 256, 0, stream>>>(MIX, Wout + (size_t)DM * DM, out, HM, 0, out, nullptr); k_rownorm<<<NTOK / 4, 256, 0, stream>>>(out, HM, 0, fin_g, XN, rowp + (size_t)2 * MPAD * 16); }
    }
    if ((OPT_MASK >> 9) & 1) mk(9); else k_final<<<NREAL / 4, 256, 0, stream>>>(out, fin_g);
}
```

```cpp
#include <hip/hip_runtime.h>
#include <cstdio>
#include <cstdint>
#include <cmath>

typedef unsigned short bf16_t;
typedef short bf16x8 __attribute__((ext_vector_type(8)));
typedef float f32x4 __attribute__((ext_vector_type(4)));
typedef unsigned u32x4 __attribute__((ext_vector_type(4)));
typedef unsigned u32x2 __attribute__((ext_vector_type(2)));

constexpr int DM = 1024, NB = 8, SEQ = 4096, NMETA = 16;
constexpr int NREAL = NB * SEQ;
constexpr int NTOK = NREAL + NB * NMETA;
constexpr int MPAD = 33024;
constexpr int INC = 5376;
constexpr int KVROWS = 4160;
constexpr float EPS = 1e-6f;
constexpr float LOG2E = 1.4426950408889634f;
constexpr float C2 = 0.125f * LOG2E;
constexpr int C_QA = 0, C_KA = 512, C_VA = 640, C_ZA = 768, C_QB = 1280, C_KB = 1792, C_VB = 2304, C_ZB = 2816, C_GA = 3328, C_GB = 4352;

constexpr size_t MiB = 1u << 20;
constexpr size_t WS_CTL = 0, WS_ROPE = 1 * MiB, WS_HM = 3 * MiB;
constexpr size_t WS_WIN_N = 4 * MiB, WS_WIN_P = 25 * MiB, WS_WOA = 46 * MiB, WS_WOB = 48 * MiB, WS_WOUT = 50 * MiB, WS_WOC = 54 * MiB, WS_WOUT_P = 58 * MiB;
constexpr size_t WS_XN = 62 * MiB, WS_QA = 127 * MiB, WS_QB = 160 * MiB, WS_MIX = 127 * MiB;
constexpr size_t WS_Z = 193 * MiB, WS_KA = 258 * MiB, WS_VA = 267 * MiB, WS_KB = 276 * MiB, WS_VB = 309 * MiB;
constexpr size_t WS_GA = 342 * MiB, WS_GB = 407 * MiB, WS_ROWP = 472 * MiB, WS_END = 479 * MiB;

__device__ __forceinline__ unsigned f2bf(float f) { unsigned u = __builtin_bit_cast(unsigned, f); return (u + 0x7fffu + ((u >> 16) & 1u)) >> 16; }
__device__ __forceinline__ float bf2f(unsigned h) { return __builtin_bit_cast(float, h << 16); }
__device__ __forceinline__ unsigned pk2(float lo, float hi) { return f2bf(lo) | (f2bf(hi) << 16); }
__device__ __forceinline__ float wave_sum(float v) {
#pragma unroll
    for (int o = 1; o < 64; o <<= 1) v += __shfl_xor(v, o);
    return v;
}
__device__ __forceinline__ float sigmoidf_(float x) { return 1.f / (1.f + __expf(-x)); }

struct RowInfo { int b, lp, gy, gx; bool valid; };
__device__ __forceinline__ RowInfo row_info(int r) {
    RowInfo i;
    if (r < NREAL) { i.b = r >> 12; const int s = r & 4095; i.lp = 64 + s; i.gy = s >> 6; i.gx = s & 63; i.valid = true; }
    else { const int q = r - NREAL; i.b = (q >> 4) & 7; i.lp = q & 15; i.gy = 0; i.gx = 0; i.valid = r < NTOK; }
    return i;
}

__global__ void __launch_bounds__(256) k_transpose(const float* __restrict__ W, bf16_t* __restrict__ Wt, int K, int N) {
    __shared__ float tile[32][33];
    const int n0 = blockIdx.x * 32, k0 = blockIdx.y * 32, tx = threadIdx.x & 31, ty = threadIdx.x >> 5;
#pragma unroll
    for (int i = 0; i < 4; ++i) tile[ty + 8 * i][tx] = W[(size_t)(k0 + ty + 8 * i) * N + n0 + tx];
    __syncthreads();
#pragma unroll
    for (int i = 0; i < 4; ++i) Wt[(size_t)(n0 + ty + 8 * i) * K + k0 + tx] = (bf16_t)f2bf(tile[tx][ty + 8 * i]);
}
__global__ void __launch_bounds__(256) k_misc(float* rope, bf16_t* KA, bf16_t* VA, bf16_t* KB, bf16_t* VB, bf16_t* XN, bf16_t* Z, float* rowss) {
    const int gt = blockIdx.x * 256 + threadIdx.x, nt = gridDim.x * 256;
    for (int i = gt; i < 64 * 16; i += nt) { const int pos = i >> 4, k = i & 15; const float inv = powf(10000.f, -(float)k / 16.f); const float a = (float)pos * inv; rope[i] = cosf(a); rope[1024 + i] = sinf(a); }
    for (int i = gt; i < NB * 2 * 3072; i += nt) { const int hh = i / 3072, e = i % 3072; KA[(size_t)hh * KVROWS * 64 + 1024 + e] = 0; VA[(size_t)hh * KVROWS * 64 + 1024 + e] = 0; }
    for (int i = gt; i < NB * 8 * 3072; i += nt) { const int hh = i / 3072, e = i % 3072; KB[(size_t)hh * KVROWS * 64 + 1024 + e] = 0; VB[(size_t)hh * KVROWS * 64 + 1024 + e] = 0; }
    for (int i = gt; i < (MPAD - NTOK) * 1024; i += nt) XN[(size_t)NTOK * 1024 + i] = 0;
    for (int i = gt; i < (MPAD - NTOK) * 1024; i += nt) Z[(size_t)NTOK * 1024 + i] = 0;
    for (int i = gt; i < 3 * (MPAD - NTOK) * 16; i += nt) { const int st = i / ((MPAD - NTOK) * 16), e = i % ((MPAD - NTOK) * 16); rowss[((size_t)st * MPAD + NTOK) * 16 + e] = (e & 15) ? 0.f : 1024.f; }
}
__global__ void __launch_bounds__(256) k_rownorm(const float* __restrict__ hreal, const float* __restrict__ hmeta, int meta_bcast, const float* __restrict__ g, bf16_t* __restrict__ XN, float* __restrict__ rowss) {
    const int lane = threadIdx.x & 63, r = blockIdx.x * 4 + (threadIdx.x >> 6);
    if (r >= NTOK) return;
    const float* src = (r < NREAL) ? hreal + (size_t)r * DM : hmeta + (size_t)(meta_bcast ? ((r - NREAL) & 15) : (r - NREAL)) * DM;
    float ss = 0.f; f32x4 v[4];
#pragma unroll
    for (int j = 0; j < 4; ++j) { v[j] = *(const f32x4*)(src + 256 * j + 4 * lane); ss += v[j].x * v[j].x + v[j].y * v[j].y + v[j].z * v[j].z + v[j].w * v[j].w; }
    ss = wave_sum(ss);
#pragma unroll
    for (int j = 0; j < 4; ++j) { const f32x4 gg = *(const f32x4*)(g + 256 * j + 4 * lane); u32x2 o; o.x = pk2(v[j].x * gg.x, v[j].y * gg.y); o.y = pk2(v[j].z * gg.z, v[j].w * gg.w); *(u32x2*)(XN + (size_t)r * DM + 256 * j + 4 * lane) = o; }
    if (lane < 16) rowss[(size_t)r * 16 + lane] = lane ? 0.f : ss;
}
__global__ void __launch_bounds__(256) k_final(float* __restrict__ out, const float* __restrict__ g) {
    const int lane = threadIdx.x & 63, r = blockIdx.x * 4 + (threadIdx.x >> 6);
    if (r >= NREAL) return;
    float* p = out + (size_t)r * DM; float ss = 0.f; f32x4 v[4];
#pragma unroll
    for (int j = 0; j < 4; ++j) { v[j] = *(const f32x4*)(p + 256 * j + 4 * lane); ss += v[j].x * v[j].x + v[j].y * v[j].y + v[j].z * v[j].z + v[j].w * v[j].w; }
    ss = wave_sum(ss); const float rstd = rsqrtf(ss * (1.f / DM) + EPS);
#pragma unroll
    for (int j = 0; j < 4; ++j) { const f32x4 gg = *(const f32x4*)(g + 256 * j + 4 * lane); *(f32x4*)(p + 256 * j + 4 * lane) = v[j] * rstd * gg; }
}

__device__ __forceinline__ void wave_gemm(const bf16_t* __restrict__ A, int lda, const bf16_t* __restrict__ Bt, int ldb, int row0, int col0, int K, f32x4 (&acc)[4]) {
    const int lane = threadIdx.x & 63;
    const bf16_t* ap = A + (size_t)(row0 + (lane & 15)) * lda + 8 * (lane >> 4);
    const bf16_t* bp = Bt + (size_t)(col0 + (lane & 15)) * ldb + 8 * (lane >> 4);
    for (int k0 = 0; k0 < K; k0 += 32) {
        const bf16x8 a = *(const bf16x8*)(ap + k0);
#pragma unroll
        for (int n = 0; n < 4; ++n) { const bf16x8 b = *(const bf16x8*)(bp + (size_t)n * 16 * ldb + k0); acc[n] = __builtin_amdgcn_mfma_f32_16x16x32_bf16(b, a, acc[n], 0, 0, 0); }
    }
}

struct InArgs { const bf16_t* XN; const bf16_t* Wt; const float* rowss; const float* qg; const float* kg; const float* rope;
                bf16_t *QA, *KA, *VA, *Z, *QB, *KB, *VB, *GA, *GB; };
__global__ void __launch_bounds__(256) k_inproj_naive(InArgs a) {
    const int lane = threadIdx.x & 63, w = threadIdx.x >> 6, fr = lane & 15, fq = lane >> 4;
    const int c0 = blockIdx.x * 64, row0 = blockIdx.y * 64 + w * 16, r = row0 + fr;
    f32x4 acc[4] = {};
    wave_gemm(a.XN, DM, a.Wt, DM, row0, c0, DM, acc);
    const RowInfo ri = row_info(r);
    float ssr = 0.f;
#pragma unroll
    for (int i = 0; i < 16; ++i) ssr += a.rowss[(size_t)r * 16 + i];
    const float rstd = rsqrtf(ssr * (1.f / DM) + EPS);
    float x[4][4];
#pragma unroll
    for (int n = 0; n < 4; ++n)
#pragma unroll
        for (int j = 0; j < 4; ++j) x[n][j] = acc[n][j] * rstd;
    const bool is_qa = c0 < C_KA, is_ka = c0 >= C_KA && c0 < C_VA;
    if (is_qa || is_ka) {
        float ss = 0.f;
#pragma unroll
        for (int n = 0; n < 4; ++n)
#pragma unroll
            for (int j = 0; j < 4; ++j) ss += x[n][j] * x[n][j];
        ss += __shfl_xor(ss, 16); ss += __shfl_xor(ss, 32);
        const float rn = rsqrtf(ss * (1.f / 64.f) + EPS);
        const float* g = is_qa ? a.qg : a.kg;
#pragma unroll
        for (int n = 0; n < 4; ++n)
#pragma unroll
            for (int j = 0; j < 4; ++j) x[n][j] = x[n][j] * rn * g[16 * n + 4 * fq + j];
        float y[4][4];
#pragma unroll
        for (int n = 0; n < 4; ++n) {
            const int pos = (n < 2) ? ri.gy : ri.gx;
#pragma unroll
            for (int j = 0; j < 4; ++j) { const float c = a.rope[pos * 16 + 4 * fq + j], s = a.rope[1024 + pos * 16 + 4 * fq + j];
                y[n][j] = (n & 1) ? (x[n][j] * c + x[n ^ 1][j] * s) : (x[n][j] * c - x[n ^ 1][j] * s); }
        }
        const float sc = is_qa ? C2 : 1.f;
#pragma unroll
        for (int n = 0; n < 4; ++n)
#pragma unroll
            for (int j = 0; j < 4; ++j) x[n][j] = y[n][j] * sc;
    }
    if (!ri.valid) return;
    bf16_t* dst; float sc = 1.f; int mode = 0;
    if (c0 < C_KA) dst = a.QA + (size_t)r * 512 + c0;
    else if (c0 < C_VA) dst = a.KA + ((size_t)(ri.b * 2 + (c0 - C_KA) / 64) * KVROWS + ri.lp) * 64;
    else if (c0 < C_ZA) dst = a.VA + ((size_t)(ri.b * 2 + (c0 - C_VA) / 64) * KVROWS + ri.lp) * 64;
    else if (c0 < C_QB) { dst = a.Z + (size_t)r * 1024 + (c0 - C_ZA); mode = 1; }
    else if (c0 < C_KB) { dst = a.QB + (size_t)r * 512 + (c0 - C_QB); sc = C2; }
    else if (c0 < C_VB) dst = a.KB + ((size_t)(ri.b * 8 + (c0 - C_KB) / 64) * KVROWS + ri.lp) * 64;
    else if (c0 < C_ZB) dst = a.VB + ((size_t)(ri.b * 8 + (c0 - C_VB) / 64) * KVROWS + ri.lp) * 64;
    else if (c0 < C_GA) { dst = a.Z + (size_t)r * 1024 + 512 + (c0 - C_ZB); mode = 1; }
    else if (c0 < C_GB) { dst = a.GA + (size_t)r * 1024 + (c0 - C_GA); mode = 2; }
    else { dst = a.GB + (size_t)r * 1024 + (c0 - C_GB); mode = 2; }
#pragma unroll
    for (int n = 0; n < 4; ++n) {
        float v[4];
#pragma unroll
        for (int j = 0; j < 4; ++j) { float t = x[n][j] * sc; if (mode == 1) t = t * sigmoidf_(t); else if (mode == 2) t = sigmoidf_(t); v[j] = t; }
        u32x2 o; o.x = pk2(v[0], v[1]); o.y = pk2(v[2], v[3]);
        *(u32x2*)(dst + 16 * n + 4 * fq) = o;
    }
}

__global__ void __launch_bounds__(256) k_mix_naive(const bf16_t* OA, const bf16_t* OB, const bf16_t* WoA, const bf16_t* WoB, const bf16_t* GA, const bf16_t* GB, bf16_t* MIX) {
    const int lane = threadIdx.x & 63, w = threadIdx.x >> 6, fr = lane & 15, fq = lane >> 4;
    const int c0 = blockIdx.x * 64, row0 = blockIdx.y * 64 + w * 16, r = row0 + fr;
    f32x4 a1[4] = {}, a2[4] = {};
    wave_gemm(OA, 1024, WoA, 512, row0, c0, 512, a1);
    wave_gemm(OB, 1024, WoB, 512, row0, c0, 512, a2);
    if (r >= NTOK) return;
#pragma unroll
    for (int n = 0; n < 4; ++n) {
        const u32x2 ga = *(const u32x2*)(GA + (size_t)r * 1024 + c0 + 16 * n + 4 * fq), gb = *(const u32x2*)(GB + (size_t)r * 1024 + c0 + 16 * n + 4 * fq);
        float v[4];
        v[0] = bf2f(ga.x & 0xffff) * a1[n][0] + bf2f(gb.x & 0xffff) * a2[n][0]; v[1] = bf2f(ga.x >> 16) * a1[n][1] + bf2f(gb.x >> 16) * a2[n][1];
        v[2] = bf2f(ga.y & 0xffff) * a1[n][2] + bf2f(gb.y & 0xffff) * a2[n][2]; v[3] = bf2f(ga.y >> 16) * a1[n][3] + bf2f(gb.y >> 16) * a2[n][3];
        u32x2 o; o.x = pk2(v[0], v[1]); o.y = pk2(v[2], v[3]);
        *(u32x2*)(MIX + (size_t)r * 1024 + c0 + 16 * n + 4 * fq) = o;
    }
}
__global__ void __launch_bounds__(256) k_out_naive(const bf16_t* MIX, const bf16_t* Wout, const float* rreal, const float* rmeta, int meta_bcast, float* oreal, float* ometa) {
    const int lane = threadIdx.x & 63, w = threadIdx.x >> 6, fr = lane & 15, fq = lane >> 4;
    const int c0 = blockIdx.x * 64, row0 = blockIdx.y * 64 + w * 16, r = row0 + fr;
    f32x4 acc[4] = {};
    wave_gemm(MIX, 1024, Wout, 1024, row0, c0, 1024, acc);
    if (r >= NTOK) return;
    const float* rs; float* od;
    if (r < NREAL) { rs = rreal + (size_t)r * DM; od = oreal + (size_t)r * DM; }
    else { rs = rmeta + (size_t)(meta_bcast ? ((r - NREAL) & 15) : (r - NREAL)) * DM; od = ometa ? ometa + (size_t)(r - NREAL) * DM : nullptr; }
    if (!od) return;
#pragma unroll
    for (int n = 0; n < 4; ++n) { const f32x4 rv = *(const f32x4*)(rs + c0 + 16 * n + 4 * fq); *(f32x4*)(od + c0 + 16 * n + 4 * fq) = rv + acc[n]; }
}

__global__ void __launch_bounds__(256) k_gqa_naive(const bf16_t* __restrict__ QA, const bf16_t* __restrict__ KA, const bf16_t* __restrict__ VA, bf16_t* ZA) {
    __shared__ __attribute__((aligned(16))) bf16_t Ks[64 * 64];
    __shared__ __attribute__((aligned(16))) bf16_t Vs[64 * 64];
    const int blk = blockIdx.x, h = blockIdx.y, b = blockIdx.z, t = threadIdx.x, kvh = h >> 2;
    int r; bool active = true;
    if (blk < 16) r = b * 4096 + blk * 256 + t; else { active = t < 16; r = NREAL + b * 16 + (active ? t : 0); }
    float q[64], o[64];
    {
        const bf16_t* qp = QA + (size_t)r * 512 + h * 64;
#pragma unroll
        for (int c = 0; c < 8; ++c) { const u32x4 v = *(const u32x4*)(qp + 8 * c);
            q[8 * c + 0] = bf2f(v.x & 0xffff); q[8 * c + 1] = bf2f(v.x >> 16); q[8 * c + 2] = bf2f(v.y & 0xffff); q[8 * c + 3] = bf2f(v.y >> 16);
            q[8 * c + 4] = bf2f(v.z & 0xffff); q[8 * c + 5] = bf2f(v.z >> 16); q[8 * c + 6] = bf2f(v.w & 0xffff); q[8 * c + 7] = bf2f(v.w >> 16); }
    }
#pragma unroll
    for (int d = 0; d < 64; ++d) o[d] = 0.f;
    float m = -INFINITY, l = 0.f;
    const bf16_t* Kb = KA + (size_t)(b * 2 + kvh) * KVROWS * 64; const bf16_t* Vb = VA + (size_t)(b * 2 + kvh) * KVROWS * 64;
    for (int tile = 0; tile < 65; ++tile) {
        __syncthreads();
#pragma unroll
        for (int i = 0; i < 2; ++i) { const int e = (t + 256 * i) * 8; *(u32x4*)(Ks + e) = *(const u32x4*)(Kb + (size_t)tile * 4096 + e); *(u32x4*)(Vs + e) = *(const u32x4*)(Vb + (size_t)tile * 4096 + e); }
        __syncthreads();
        const int nvalid = tile == 0 ? 16 : 64;
#pragma unroll 1
        for (int j = 0; j < nvalid; ++j) {
            float acc = 0.f;
#pragma unroll
            for (int c = 0; c < 8; ++c) { const u32x4 v = *(const u32x4*)(Ks + j * 64 + 8 * c);
                acc += q[8 * c + 0] * bf2f(v.x & 0xffff) + q[8 * c + 1] * bf2f(v.x >> 16) + q[8 * c + 2] * bf2f(v.y & 0xffff) + q[8 * c + 3] * bf2f(v.y >> 16)
                     + q[8 * c + 4] * bf2f(v.z & 0xffff) + q[8 * c + 5] * bf2f(v.z >> 16) + q[8 * c + 6] * bf2f(v.w & 0xffff) + q[8 * c + 7] * bf2f(v.w >> 16); }
            if (acc > m) { const float sc = exp2f(m - acc); m = acc; l *= sc;
#pragma unroll
                for (int d = 0; d < 64; ++d) o[d] *= sc; }
            const float p = exp2f(acc - m); l += p;
#pragma unroll
            for (int c = 0; c < 8; ++c) { const u32x4 v = *(const u32x4*)(Vs + j * 64 + 8 * c);
                o[8 * c + 0] += p * bf2f(v.x & 0xffff); o[8 * c + 1] += p * bf2f(v.x >> 16); o[8 * c + 2] += p * bf2f(v.y & 0xffff); o[8 * c + 3] += p * bf2f(v.y >> 16);
                o[8 * c + 4] += p * bf2f(v.z & 0xffff); o[8 * c + 5] += p * bf2f(v.z >> 16); o[8 * c + 6] += p * bf2f(v.w & 0xffff); o[8 * c + 7] += p * bf2f(v.w >> 16); }
        }
    }
    if (!active) return;
    const float inv = 1.f / l; bf16_t* zp = ZA + (size_t)r * 1024 + h * 64;
#pragma unroll
    for (int c = 0; c < 8; ++c) { const u32x4 z = *(const u32x4*)(zp + 8 * c); u32x4 w;
        w.x = pk2(o[8 * c + 0] * inv * bf2f(z.x & 0xffff), o[8 * c + 1] * inv * bf2f(z.x >> 16)); w.y = pk2(o[8 * c + 2] * inv * bf2f(z.y & 0xffff), o[8 * c + 3] * inv * bf2f(z.y >> 16));
        w.z = pk2(o[8 * c + 4] * inv * bf2f(z.z & 0xffff), o[8 * c + 5] * inv * bf2f(z.z >> 16)); w.w = pk2(o[8 * c + 6] * inv * bf2f(z.w & 0xffff), o[8 * c + 7] * inv * bf2f(z.w >> 16));
        *(u32x4*)(zp + 8 * c) = w; }
}

__global__ void __launch_bounds__(64) k_na_naive(const bf16_t* __restrict__ QB, const bf16_t* __restrict__ KB, const bf16_t* __restrict__ VB, bf16_t* ZB, const float* __restrict__ rpb) {
    const int gyb = blockIdx.x, h = blockIdx.y, b = blockIdx.z, t = threadIdx.x;
    int r, gy = 0, gx = 0; bool active = true, meta = gyb == 64;
    if (!meta) { gy = gyb; gx = t; r = b * 4096 + gy * 64 + gx; } else { active = t < 16; r = NREAL + b * 16 + (active ? t : 0); }
    const int rs = min(max(gy - 4, 0), 56), cs = min(max(gx - 8, 0), 48);
    float q[64], o[64];
    {
        const bf16_t* qp = QB + (size_t)r * 512 + h * 64;
#pragma unroll
        for (int c = 0; c < 8; ++c) { const u32x4 v = *(const u32x4*)(qp + 8 * c);
            q[8 * c + 0] = bf2f(v.x & 0xffff); q[8 * c + 1] = bf2f(v.x >> 16); q[8 * c + 2] = bf2f(v.y & 0xffff); q[8 * c + 3] = bf2f(v.y >> 16);
            q[8 * c + 4] = bf2f(v.z & 0xffff); q[8 * c + 5] = bf2f(v.z >> 16); q[8 * c + 6] = bf2f(v.w & 0xffff); q[8 * c + 7] = bf2f(v.w >> 16); }
    }
#pragma unroll
    for (int d = 0; d < 64; ++d) o[d] = 0.f;
    float m = -INFINITY, l = 0.f;
    const bf16_t* Kb = KB + (size_t)(b * 8 + h) * KVROWS * 64; const bf16_t* Vb = VB + (size_t)(b * 8 + h) * KVROWS * 64;
    const float* rp = rpb + h * 15 * 31;
#pragma unroll 1
    for (int ch = meta ? 8 : 0; ch < 9; ++ch) {
        const int kr = rs + ch; const size_t rowbase = (ch < 8) ? (size_t)(64 + kr * 64 + cs) : 0;
#pragma unroll 1
        for (int jj = 0; jj < 16; ++jj) {
            const bf16_t* kp = Kb + (rowbase + jj) * 64; float acc = 0.f;
#pragma unroll
            for (int c = 0; c < 8; ++c) { const u32x4 v = *(const u32x4*)(kp + 8 * c);
                acc += q[8 * c + 0] * bf2f(v.x & 0xffff) + q[8 * c + 1] * bf2f(v.x >> 16) + q[8 * c + 2] * bf2f(v.y & 0xffff) + q[8 * c + 3] * bf2f(v.y >> 16)
                     + q[8 * c + 4] * bf2f(v.z & 0xffff) + q[8 * c + 5] * bf2f(v.z >> 16) + q[8 * c + 6] * bf2f(v.w & 0xffff) + q[8 * c + 7] * bf2f(v.w >> 16); }
            if (ch < 8) acc += rp[(kr - gy + 7) * 31 + (cs + jj - gx + 15)] * LOG2E;
            if (acc > m) { const float sc = exp2f(m - acc); m = acc; l *= sc;
#pragma unroll
                for (int d = 0; d < 64; ++d) o[d] *= sc; }
            const float p = exp2f(acc - m); l += p; const bf16_t* vp = Vb + (rowbase + jj) * 64;
#pragma unroll
            for (int c = 0; c < 8; ++c) { const u32x4 v = *(const u32x4*)(vp + 8 * c);
                o[8 * c + 0] += p * bf2f(v.x & 0xffff); o[8 * c + 1] += p * bf2f(v.x >> 16); o[8 * c + 2] += p * bf2f(v.y & 0xffff); o[8 * c + 3] += p * bf2f(v.y >> 16);
                o[8 * c + 4] += p * bf2f(v.z & 0xffff); o[8 * c + 5] += p * bf2f(v.z >> 16); o[8 * c + 6] += p * bf2f(v.w & 0xffff); o[8 * c + 7] += p * bf2f(v.w >> 16); }
        }
    }
    if (!active) return;
    const float inv = 1.f / l; bf16_t* zp = ZB + (size_t)r * 1024 + h * 64;
#pragma unroll
    for (int c = 0; c < 8; ++c) { const u32x4 z = *(const u32x4*)(zp + 8 * c); u32x4 w;
        w.x = pk2(o[8 * c + 0] * inv * bf2f(z.x & 0xffff), o[8 * c + 1] * inv * bf2f(z.x >> 16)); w.y = pk2(o[8 * c + 2] * inv * bf2f(z.y & 0xffff), o[8 * c + 3] * inv * bf2f(z.y >> 16));
        w.z = pk2(o[8 * c + 4] * inv * bf2f(z.z & 0xffff), o[8 * c + 5] * inv * bf2f(z.z >> 16)); w.w = pk2(o[8 * c + 6] * inv * bf2f(z.w & 0xffff), o[8 * c + 7] * inv * bf2f(z.w >> 16));
        *(u32x4*)(zp + 8 * c) = w; }
}

namespace pg8 {
#define PG8_LAS __attribute__((address_space(3)))
typedef unsigned short bf16_t;
typedef short bf16x8 __attribute__((ext_vector_type(8)));
typedef float f32x4 __attribute__((ext_vector_type(4)));
typedef unsigned u32x4 __attribute__((ext_vector_type(4)));
constexpr int BM = 256, BK = 64, HALF = 128, HTB = HALF * BK * 2  , STAGE_BYTES = 8 * HTB, NXCD = 8, WGM = 8;

__host__ __device__ __forceinline__ int lds_byte(int r, int c) { const int st = (r >> 4) * 2 + (c >> 5), rr = r & 15, cc = c & 31, ob = rr * 64 + cc * 2; return st * 1024 + (ob ^ (((ob >> 9) & 1) << 5)); }
__host__ __device__ __forceinline__ void stage_rc(int b, int& R, int& C) { const int st = b / 1024, sb = b % 1024, swz = sb ^ (((sb >> 9) & 1) << 5); R = (st >> 1) * 16 + swz / 64; C = (st & 1) * 32 + (swz % 64) / 2; }
__host__ __device__ __forceinline__ int perm32(int rho) { const int n = rho >> 4, i = rho & 15; return 8 * (i >> 2) + 4 * n + (i & 3); }

struct Unit { int pm, pn; };
struct Gemm { const bf16_t* A; const bf16_t* Bt; int M, N, K; };

struct StaticOrder {
    int nM, nN, nwg, G, c;
    __host__ __device__ void init(int M, int N, int G_, int c_) { nM = M / BM; nN = N / BM; nwg = nM * nN; G = G_; c = c_; }
    __host__ __device__ bool next(int i, Unit& u) const {
        const long L = (long)i * G + c; if (L >= nwg) return false;
        int wgid = (int)L; { const int q = nwg / NXCD, r = nwg % NXCD, xcd = wgid % NXCD, off = wgid / NXCD; wgid = (xcd < r ? xcd * (q + 1) : r * (q + 1) + (xcd - r) * q) + off; }
        const int nig = WGM * nN, gid = wgid / nig, fm = gid * WGM, gsz = (nM - fm) < WGM ? (nM - fm) : WGM;
        u.pm = fm + ((wgid % nig) % gsz); u.pn = (wgid % nig) / gsz; return true;
    }
    __device__ __forceinline__ void a_ready(const Unit&) const {}
    __device__ __forceinline__ void done(const Unit&) const {}
};
__device__ __forceinline__ unsigned cvt_pk_bf16(float lo, float hi) { unsigned r; asm volatile("v_cvt_pk_bf16_f32 %0, %1, %2" : "=v"(r) : "v"(lo), "v"(hi)); return r; }

__device__ __forceinline__ float rowp_rstd(const float* rowp, int r) {
    const f32x4* p = (const f32x4*)(rowp + (size_t)r * 16); const f32x4 a = p[0], b = p[1], c = p[2], d = p[3];
    const float ss = ((a[0] + a[1]) + (a[2] + a[3])) + ((b[0] + b[1]) + (b[2] + b[3])) + ((c[0] + c[1]) + (c[2] + c[3])) + ((d[0] + d[1]) + (d[2] + d[3]));
    return rsqrtf(ss * (1.f / DM) + EPS);
}
struct EpiIn {
    static constexpr bool PERM = false, AFTER_DRAIN = false, MID = false;
    const float* rowp; const float* qg; const float* kg; const float* rope;
    bf16_t *QA, *KA, *VA, *Z, *QB, *KB, *VB, *GA, *GB;
    template <bool NR> __device__ __forceinline__ void head_rows(const f32x4 (&acc)[2][2][4][2], int rbase, int fq, const float* g, float scale, bool kv, bf16_t* dst, int nh, int head) const {
        const int fq1 = fq >> 1, fq0 = fq & 1, dl = 32 * fq1 + 8 * fq0;
        f32x4 gv[2][2];
        if (NR) {
#pragma unroll
            for (int bj = 0; bj < 2; ++bj)
#pragma unroll
                for (int n = 0; n < 2; ++n) gv[bj][n] = *(const f32x4*)(g + dl + 16 * bj + 4 * n);
        }
#pragma unroll
        for (int ai = 0; ai < 2; ++ai)
#pragma unroll
            for (int m = 0; m < 4; ++m) {
                const int r = rbase + ai * HALF + m * 16; const RowInfo ri = row_info(r);
                const float rstd = rowp_rstd(rowp, r);
                f32x4 x[2][2];
#pragma unroll
                for (int bj = 0; bj < 2; ++bj)
#pragma unroll
                    for (int n = 0; n < 2; ++n) x[bj][n] = acc[ai][bj][m][n] * rstd;
                if (NR) {
                    float ss = 0.f;
#pragma unroll
                    for (int bj = 0; bj < 2; ++bj)
#pragma unroll
                        for (int n = 0; n < 2; ++n) { const f32x4 t = x[bj][n]; ss += (t[0] * t[0] + t[1] * t[1]) + (t[2] * t[2] + t[3] * t[3]); }
                    ss += __shfl_xor(ss, 16); ss += __shfl_xor(ss, 32);
                    const float rn = rsqrtf(ss * (1.f / 64.f) + EPS);
                    const int pos = fq1 ? ri.gx : ri.gy;
#pragma unroll
                    for (int n = 0; n < 2; ++n) {
                        const f32x4 c = *(const f32x4*)(rope + pos * 16 + 8 * fq0 + 4 * n), sn = *(const f32x4*)(rope + 1024 + pos * 16 + 8 * fq0 + 4 * n);
                        const f32x4 a0 = x[0][n] * rn * gv[0][n], a1 = x[1][n] * rn * gv[1][n];
                        x[0][n] = a0 * c - a1 * sn; x[1][n] = a1 * c + a0 * sn;
                    }
                }
                if (ri.valid) {
                    bf16_t* rowp_ = kv ? dst + ((size_t)(ri.b * nh + head) * KVROWS + ri.lp) * 64 : dst + (size_t)r * 512 + head * 64;
#pragma unroll
                    for (int bj = 0; bj < 2; ++bj) { const f32x4 v0 = x[bj][0] * scale, v1 = x[bj][1] * scale; u32x4 w; w.x = cvt_pk_bf16(v0[0], v0[1]); w.y = cvt_pk_bf16(v0[2], v0[3]); w.z = cvt_pk_bf16(v1[0], v1[1]); w.w = cvt_pk_bf16(v1[2], v1[3]);
                        *(u32x4*)(rowp_ + dl + 16 * bj) = w; }
                }
                asm volatile("" ::: "memory");
            }
    }
    template <int ACT> __device__ __forceinline__ void elem_rows(const f32x4 (&acc)[2][2][4][2], int rbase, int wc, int fq, bf16_t* dst, int colbase) const {
#pragma unroll
        for (int ai = 0; ai < 2; ++ai)
#pragma unroll
            for (int m = 0; m < 4; ++m) {
                const int r = rbase + ai * HALF + m * 16; const float rstd = rowp_rstd(rowp, r);
                if (r < NTOK) {
#pragma unroll
                    for (int bj = 0; bj < 2; ++bj) { float v[8];
#pragma unroll
                        for (int n = 0; n < 2; ++n)
#pragma unroll
                            for (int j = 0; j < 4; ++j) { const float t = acc[ai][bj][m][n][j] * rstd; const float sg = __builtin_amdgcn_rcpf(1.f + __builtin_amdgcn_exp2f(-LOG2E * t)); v[4 * n + j] = ACT == 1 ? t * sg : sg; }
                        u32x4 w; w.x = cvt_pk_bf16(v[0], v[1]); w.y = cvt_pk_bf16(v[2], v[3]); w.z = cvt_pk_bf16(v[4], v[5]); w.w = cvt_pk_bf16(v[6], v[7]);
                        *(u32x4*)(dst + (size_t)r * 1024 + colbase + 128 * bj + 32 * wc + 8 * fq) = w; }
                }
                asm volatile("" ::: "memory");
            }
    }
    __device__ __forceinline__ void operator()(const f32x4 (&acc)[2][2][4][2], const Unit& u, int wr, int wc, int fr, int fq) const {
        asm volatile("" : "+v"(fr), "+v"(fq));
        const int rbase = u.pm * BM + wr * 64 + fr, t = u.pn;
        if (t < 2) head_rows<true>(acc, rbase, fq, qg, C2, false, QA, 0, 4 * t + wc);
        else if (t == 2) { if (wc < 2) head_rows<true>(acc, rbase, fq, kg, 1.f, true, KA, 2, wc); else head_rows<false>(acc, rbase, fq, nullptr, 1.f, true, VA, 2, wc - 2); }
        else if (t < 5) elem_rows<1>(acc, rbase, wc, fq, Z, (t - 3) * 256);
        else if (t < 7) head_rows<false>(acc, rbase, fq, nullptr, C2, false, QB, 0, 4 * (t - 5) + wc);
        else if (t < 9) head_rows<false>(acc, rbase, fq, nullptr, 1.f, true, KB, 8, 4 * (t - 7) + wc);
        else if (t < 11) head_rows<false>(acc, rbase, fq, nullptr, 1.f, true, VB, 8, 4 * (t - 9) + wc);
        else if (t < 13) elem_rows<1>(acc, rbase, wc, fq, Z, 512 + (t - 11) * 256);
        else if (t < 17) elem_rows<2>(acc, rbase, wc, fq, GA, (t - 13) * 256);
        else elem_rows<2>(acc, rbase, wc, fq, GB, (t - 17) * 256);
    }
};
struct EpiMix {
    static constexpr bool PERM = false, AFTER_DRAIN = false, MID = true;
    const bf16_t* GA; const bf16_t* GB; bf16_t* MIX;
    __device__ __forceinline__ void mid(f32x4 (&acc)[2][2][4][2], const Unit& u, int wr, int wc, int fr, int fq) const {
        asm volatile("" : "+v"(fr), "+v"(fq));
        const int rbase = u.pm * BM + wr * 64 + fr, cb = u.pn * BM + 32 * wc + 8 * fq;
        const size_t off0 = (size_t)rbase * 1024 + cb;
        u32x4 ca[2], cg[2], na[2], ng[2];
#pragma unroll
        for (int bj = 0; bj < 2; ++bj) { ca[bj] = *(const u32x4*)(GA + off0 + 128 * bj); cg[bj] = *(const u32x4*)(GB + off0 + 128 * bj); }
        asm volatile("" ::: "memory");
#pragma unroll
        for (int gidx = 0; gidx < 8; ++gidx) { const int ai = gidx >> 2, m = gidx & 3;
            if (gidx < 7) { const size_t off = off0 + (size_t)(((gidx + 1) >> 2) * HALF + ((gidx + 1) & 3) * 16) * 1024;
#pragma unroll
                for (int bj = 0; bj < 2; ++bj) { na[bj] = *(const u32x4*)(GA + off + 128 * bj); ng[bj] = *(const u32x4*)(GB + off + 128 * bj); } }
#pragma unroll
            for (int bj = 0; bj < 2; ++bj)
#pragma unroll
                for (int q = 0; q < 4; ++q) { const float a0 = bf2f(ca[bj][q] & 0xffff), a1 = bf2f(ca[bj][q] >> 16), b0 = fmaxf(bf2f(cg[bj][q] & 0xffff), 1e-30f), b1 = fmaxf(bf2f(cg[bj][q] >> 16), 1e-30f);
                    acc[ai][bj][m][q >> 1][2 * (q & 1)] *= a0 * __builtin_amdgcn_rcpf(b0); acc[ai][bj][m][q >> 1][2 * (q & 1) + 1] *= a1 * __builtin_amdgcn_rcpf(b1); }
            asm volatile("" ::: "memory");
#pragma unroll
            for (int bj = 0; bj < 2; ++bj) { ca[bj] = na[bj]; cg[bj] = ng[bj]; } }
    }
    __device__ __forceinline__ void operator()(const f32x4 (&acc)[2][2][4][2], const Unit& u, int wr, int wc, int fr, int fq) const {
        asm volatile("" : "+v"(fr), "+v"(fq));
        const int rbase = u.pm * BM + wr * 64 + fr, cb = u.pn * BM + 32 * wc + 8 * fq;
        const size_t off0 = (size_t)rbase * 1024 + cb;
        u32x4 cg[2], ng[2];
#pragma unroll
        for (int bj = 0; bj < 2; ++bj) cg[bj] = *(const u32x4*)(GB + off0 + 128 * bj);
        asm volatile("" ::: "memory");
#pragma unroll
        for (int gidx = 0; gidx < 8; ++gidx) { const int ai = gidx >> 2, m = gidx & 3; const size_t off = off0 + (size_t)(ai * HALF + m * 16) * 1024;
            if (gidx < 7) { const size_t offn = off0 + (size_t)(((gidx + 1) >> 2) * HALF + ((gidx + 1) & 3) * 16) * 1024;
#pragma unroll
                for (int bj = 0; bj < 2; ++bj) ng[bj] = *(const u32x4*)(GB + offn + 128 * bj); }
#pragma unroll
            for (int bj = 0; bj < 2; ++bj) { u32x4 w;
#pragma unroll
                for (int q = 0; q < 4; ++q) { const float b0 = fmaxf(bf2f(cg[bj][q] & 0xffff), 1e-30f), b1 = fmaxf(bf2f(cg[bj][q] >> 16), 1e-30f);
                    w[q] = cvt_pk_bf16(acc[ai][bj][m][q >> 1][2 * (q & 1)] * b0, acc[ai][bj][m][q >> 1][2 * (q & 1) + 1] * b1); }
                *(u32x4*)(MIX + off + 128 * bj) = w; }
            asm volatile("" ::: "memory");
#pragma unroll
            for (int bj = 0; bj < 2; ++bj) cg[bj] = ng[bj]; }
    }
};
struct EpiOut {
    static constexpr bool PERM = false, AFTER_DRAIN = false, MID = false;
    const float* rreal; float* oreal; const float* gnext; bf16_t* XN; float* rowp;
    __device__ __forceinline__ void operator()(const f32x4 (&acc)[2][2][4][2], const Unit& u, int wr, int wc, int fr, int fq) const {
        asm volatile("" : "+v"(fr), "+v"(fq));
        const int rbase = u.pm * BM + wr * 64 + fr, cb = u.pn * BM + 32 * wc + 8 * fq;
        const size_t off0 = (size_t)rbase * DM + cb;
        f32x4 gv[2][2];
        if (XN) {
#pragma unroll
            for (int bj = 0; bj < 2; ++bj)
#pragma unroll
                for (int n = 0; n < 2; ++n) gv[bj][n] = *(const f32x4*)(gnext + cb + 128 * bj + 4 * n);
        }
        f32x4 cr[2][2], nr[2][2];
#pragma unroll
        for (int bj = 0; bj < 2; ++bj)
#pragma unroll
            for (int n = 0; n < 2; ++n) cr[bj][n] = *(const f32x4*)(rreal + off0 + 128 * bj + 4 * n);
        asm volatile("" ::: "memory");
#pragma unroll
        for (int gidx = 0; gidx < 8; ++gidx) { const int ai = gidx >> 2, m = gidx & 3; const int r = rbase + ai * HALF + m * 16; const size_t off = off0 + (size_t)(ai * HALF + m * 16) * DM;
            if (gidx < 7) { const size_t offn = off0 + (size_t)(((gidx + 1) >> 2) * HALF + ((gidx + 1) & 3) * 16) * DM;
#pragma unroll
                for (int bj = 0; bj < 2; ++bj)
#pragma unroll
                    for (int n = 0; n < 2; ++n) nr[bj][n] = *(const f32x4*)(rreal + offn + 128 * bj + 4 * n); }
            float ss = 0.f;
#pragma unroll
            for (int bj = 0; bj < 2; ++bj) { f32x4 h0 = cr[bj][0] + acc[ai][bj][m][0], h1 = cr[bj][1] + acc[ai][bj][m][1];
                ss += ((h0[0] * h0[0] + h0[1] * h0[1]) + (h0[2] * h0[2] + h0[3] * h0[3])) + ((h1[0] * h1[0] + h1[1] * h1[1]) + (h1[2] * h1[2] + h1[3] * h1[3]));
                *(f32x4*)(oreal + off + 128 * bj) = h0; *(f32x4*)(oreal + off + 128 * bj + 4) = h1;
                if (XN) { h0 = h0 * gv[bj][0]; h1 = h1 * gv[bj][1]; u32x4 w; w.x = cvt_pk_bf16(h0[0], h0[1]); w.y = cvt_pk_bf16(h0[2], h0[3]); w.z = cvt_pk_bf16(h1[0], h1[1]); w.w = cvt_pk_bf16(h1[2], h1[3]);
                    *(u32x4*)(XN + off + 128 * bj) = w; } }
            ss += __shfl_xor(ss, 16); ss += __shfl_xor(ss, 32);
            if (fq == 0) rowp[(size_t)r * 16 + 4 * u.pn + wc] = ss;
            asm volatile("" ::: "memory");
#pragma unroll
            for (int bj = 0; bj < 2; ++bj)
#pragma unroll
                for (int n = 0; n < 2; ++n) cr[bj][n] = nr[bj][n]; }
    }
};
template <class Epi, class Sched, bool ALIGN_EPI = false, bool SP2 = false>
__device__ __forceinline__ void gemm_phase(PG8_LAS unsigned char* lds, const Gemm g, const Sched& S, const Epi& E) {
    int tid_ = threadIdx.x; asm volatile("" : "+v"(tid_));
    const int tid = tid_, wid = __builtin_amdgcn_readfirstlane(tid >> 6), lane = tid & 63, wr = wid >> 2, wc = wid & 3, fr = lane & 15, fq = lane >> 4;
    const int K = g.K, nt = K / BK;
    unsigned voffA[2], voffB[2];
#pragma unroll
    for (int i = 0; i < 2; ++i) { int R, C; stage_rc(tid * 16 + i * 8192, R, C); const int Rb = Epi::PERM ? ((R & ~31) + perm32(R & 31)) : R;
        voffA[i] = (unsigned)(R * K + C) * 2u; voffB[i] = (unsigned)(Rb * K + C) * 2u; }
    const size_t kstep = (size_t)(BK * 2);
    const size_t hstep = (size_t)HALF * K * 2;
    const size_t tstep = 2 * hstep;
    const unsigned ldsw = (unsigned)wid * 1024u;
    const int aoff = lds_byte(wr * 64 + fr, fq * 8), boff = lds_byte(wc * 32 + fr, fq * 8);
#define PG8_SA(b, h) (((b) * 2 + (h)) * HTB)
#define PG8_SB(b, h) ((4 + (b) * 2 + (h)) * HTB)
#define PG8_STAGE(bufoff, gbase, voff) do { _Pragma("unroll") for (int _i = 0; _i < 2; ++_i) \
        __builtin_amdgcn_global_load_lds((const unsigned*)((const char*)(gbase) + (voff)[_i]), (PG8_LAS unsigned*)(lds + (bufoff) + ldsw + _i * 8192), 16, 0, 0); } while (0)
#define PG8_LDA(dst, b, h) do { _Pragma("unroll") for (int m = 0; m < 4; ++m) _Pragma("unroll") for (int k = 0; k < 2; ++k) dst[m][k] = *(const PG8_LAS bf16x8*)(lds + PG8_SA(b, h) + aoff + m * 2048 + k * 1024); } while (0)
#define PG8_LDB(dst, b, h) do { _Pragma("unroll") for (int n = 0; n < 2; ++n) _Pragma("unroll") for (int k = 0; k < 2; ++k) dst[n][k] = *(const PG8_LAS bf16x8*)(lds + PG8_SB(b, h) + boff + n * 2048 + k * 1024); } while (0)
#define PG8_MMA(ai, bj, At, Bt) do { __builtin_amdgcn_s_setprio(1); _Pragma("unroll") for (int m = 0; m < 4; ++m) _Pragma("unroll") for (int n = 0; n < 2; ++n) _Pragma("unroll") for (int k = 0; k < 2; ++k) \
        acc[ai][bj][m][n] = __builtin_amdgcn_mfma_f32_16x16x32_bf16(Bt[n][k], At[m][k], acc[ai][bj][m][n], 0, 0, 0); __builtin_amdgcn_s_setprio(0); } while (0)
#define PG8_WAIT_V(n) asm volatile("s_waitcnt vmcnt(" #n ")" ::: "memory")
#define PG8_WAIT_L(n) asm volatile("s_waitcnt lgkmcnt(" #n ")" ::: "memory")
#define PG8_BAR __builtin_amdgcn_s_barrier()
#define PG8_SCHED __builtin_amdgcn_sched_barrier(0)
    Unit cur, nxt; int ui = 0;
    (void)S.next(0, cur);
    f32x4 acc[2][2][4][2];
#pragma unroll
    for (int a = 0; a < 2; ++a)
#pragma unroll
        for (int b = 0; b < 2; ++b)
#pragma unroll
            for (int m = 0; m < 4; ++m)
#pragma unroll
                for (int n = 0; n < 2; ++n) acc[a][b][m][n] = (f32x4){0.f, 0.f, 0.f, 0.f};
    bf16x8 At[4][2], B0[2][2], B1[2][2];
    const char* cA = (const char*)g.A + (size_t)cur.pm * tstep; const char* cB = (const char*)g.Bt + (size_t)cur.pn * tstep;
    S.a_ready(cur);
    if constexpr (SP2) {
        PG8_STAGE(PG8_SB(0, 0), cB, voffB); PG8_STAGE(PG8_SB(0, 1), cB + hstep, voffB); PG8_STAGE(PG8_SA(0, 0), cA, voffA); PG8_STAGE(PG8_SA(0, 1), cA + hstep, voffA);
        if (wr == 1) PG8_BAR;
        PG8_WAIT_V(2); PG8_BAR;
        PG8_STAGE(PG8_SB(1, 0), cB + kstep, voffB); PG8_STAGE(PG8_SA(1, 0), cA + kstep, voffA); PG8_STAGE(PG8_SB(1, 1), cB + hstep + kstep, voffB);
        PG8_WAIT_V(6); PG8_BAR;
    } else {
        PG8_STAGE(PG8_SB(0, 0), cB, voffB); PG8_STAGE(PG8_SA(0, 0), cA, voffA); PG8_STAGE(PG8_SB(0, 1), cB + hstep, voffB); PG8_STAGE(PG8_SA(0, 1), cA + hstep, voffA);
        if (wr == 1) PG8_BAR;
        PG8_WAIT_V(4); PG8_BAR;
        PG8_STAGE(PG8_SB(1, 0), cB + kstep, voffB); PG8_STAGE(PG8_SA(1, 0), cA + kstep, voffA); PG8_STAGE(PG8_SB(1, 1), cB + hstep + kstep, voffB);
        PG8_WAIT_V(6); PG8_BAR;
    }
    for (;;) {
        const bool has_next = S.next(ui + 1, nxt);
        const char* nA = has_next ? (const char*)g.A + (size_t)nxt.pm * tstep : cA; const char* nB = has_next ? (const char*)g.Bt + (size_t)nxt.pn * tstep : cB;
        for (int t = 0; t < nt; t += 2) {
            const bool last = (t == nt - 2);
            const char* a1 = cA + (size_t)(t + 1) * kstep;
            const char* a2 = last ? nA : cA + (size_t)(t + 2) * kstep; const char* b2 = last ? nB : cB + (size_t)(t + 2) * kstep;
            const char* a3 = a2 + kstep; const char* b3 = b2 + kstep;
            if (last && has_next) S.a_ready(nxt);
            if constexpr (Epi::MID) { if (t == nt / 2) E.mid(acc, cur, wr, wc, fr, fq); }
            if constexpr (SP2) {
            PG8_LDB(B0, 0, 0); PG8_LDB(B1, 0, 1); PG8_SCHED; PG8_LDA(At, 0, 0); PG8_STAGE(PG8_SA(1, 1), a1 + hstep, voffA);
            PG8_WAIT_V(8); PG8_WAIT_L(0); PG8_BAR; PG8_MMA(0, 0, At, B0); PG8_MMA(0, 1, At, B1); PG8_BAR; PG8_SCHED;
            PG8_LDA(At, 0, 1); PG8_STAGE(PG8_SB(0, 0), b2, voffB); PG8_STAGE(PG8_SB(0, 1), b2 + hstep, voffB); PG8_STAGE(PG8_SA(0, 0), a2, voffA);
            PG8_WAIT_V(8); PG8_WAIT_L(0); PG8_BAR; PG8_MMA(1, 0, At, B0); PG8_MMA(1, 1, At, B1); PG8_BAR; PG8_SCHED;
            PG8_LDB(B0, 1, 0); PG8_LDB(B1, 1, 1); PG8_SCHED; PG8_LDA(At, 1, 0); PG8_STAGE(PG8_SA(0, 1), a2 + hstep, voffA);
            PG8_WAIT_V(8); PG8_WAIT_L(0); PG8_BAR; PG8_MMA(0, 0, At, B0); PG8_MMA(0, 1, At, B1); PG8_BAR; PG8_SCHED;
            PG8_LDA(At, 1, 1); PG8_STAGE(PG8_SB(1, 0), b3, voffB); PG8_STAGE(PG8_SB(1, 1), b3 + hstep, voffB); PG8_STAGE(PG8_SA(1, 0), a3, voffA);
            PG8_WAIT_V(8); PG8_WAIT_L(0); PG8_BAR; PG8_MMA(1, 0, At, B0); PG8_MMA(1, 1, At, B1); PG8_BAR; PG8_SCHED;
            } else {
            PG8_LDB(B0, 0, 0); PG8_SCHED; PG8_LDA(At, 0, 0); PG8_STAGE(PG8_SA(1, 1), a1 + hstep, voffA);
            PG8_WAIT_L(8); PG8_BAR; PG8_WAIT_L(0); PG8_MMA(0, 0, At, B0); PG8_BAR; PG8_SCHED;
            PG8_LDB(B1, 0, 1); PG8_STAGE(PG8_SB(0, 0), b2, voffB);
            PG8_BAR; PG8_WAIT_L(0); PG8_MMA(0, 1, At, B1); PG8_BAR;
            PG8_LDA(At, 0, 1); PG8_STAGE(PG8_SA(0, 0), a2, voffA);
            PG8_BAR; PG8_WAIT_L(0); PG8_MMA(1, 0, At, B0); PG8_BAR; PG8_SCHED;
            PG8_STAGE(PG8_SB(0, 1), b2 + hstep, voffB);
            PG8_WAIT_V(6); PG8_BAR; PG8_MMA(1, 1, At, B1); PG8_BAR;
            PG8_LDB(B0, 1, 0); PG8_SCHED; PG8_LDA(At, 1, 0); PG8_STAGE(PG8_SA(0, 1), a2 + hstep, voffA);
            PG8_WAIT_L(8); PG8_BAR; PG8_WAIT_L(0); PG8_MMA(0, 0, At, B0); PG8_BAR; PG8_SCHED;
            PG8_LDB(B1, 1, 1); PG8_STAGE(PG8_SB(1, 0), b3, voffB);
            PG8_BAR; PG8_WAIT_L(0); PG8_MMA(0, 1, At, B1); PG8_BAR;
            PG8_LDA(At, 1, 1); PG8_STAGE(PG8_SA(1, 0), a3, voffA);
            PG8_BAR; PG8_WAIT_L(0); PG8_MMA(1, 0, At, B0); PG8_BAR; PG8_SCHED;
            PG8_STAGE(PG8_SB(1, 1), b3 + hstep, voffB);
            PG8_WAIT_V(6); PG8_BAR; PG8_MMA(1, 1, At, B1); PG8_BAR;
            }
        }
        if constexpr (ALIGN_EPI) { if (wr == 0) PG8_BAR; }
        if constexpr (!Epi::AFTER_DRAIN) { E(acc, cur, wr, wc, fr, fq); S.done(cur); }
        if (!has_next) break;
#pragma unroll
        for (int a = 0; a < 2; ++a)
#pragma unroll
            for (int b = 0; b < 2; ++b)
#pragma unroll
                for (int m = 0; m < 4; ++m)
#pragma unroll
                    for (int n = 0; n < 2; ++n) acc[a][b][m][n] = (f32x4){0.f, 0.f, 0.f, 0.f};
        cur = nxt; cA = nA; cB = nB; ++ui;
        if constexpr (ALIGN_EPI) { if (wr == 1) PG8_BAR; }
    }
    PG8_WAIT_V(0);
    if constexpr (!ALIGN_EPI) { if (wr == 0) PG8_BAR; }
    PG8_BAR;
    if constexpr (Epi::AFTER_DRAIN) { E.fused(acc, cur, wr, wc, fr, fq, lds, wid, lane); S.done(cur); }
#undef PG8_SA
#undef PG8_SB
#undef PG8_STAGE
#undef PG8_LDA
#undef PG8_LDB
#undef PG8_MMA
#undef PG8_WAIT_V
#undef PG8_WAIT_L
#undef PG8_BAR
#undef PG8_SCHED
}
}

#include <hip/hip_bf16.h>
namespace attn_body {
using bf16=__hip_bfloat16;
using bf16x8=__attribute__((ext_vector_type(8)))short;
using s16x4=__attribute__((ext_vector_type(4)))short;
using f32x16=__attribute__((ext_vector_type(16)))float;
using u32x4=__attribute__((ext_vector_type(4)))unsigned;
constexpr int D=64,KVP=64;
constexpr int NW=8,QBLK=32,QB=QBLK*NW,KVBLK=64;
__device__ __forceinline__ int crow(int r,int hi){return (r&3)+8*(r>>2)+4*hi;}
#define SBAR() __builtin_amdgcn_sched_barrier(0)
__device__ __forceinline__ void mask_meta(f32x16&p0,f32x16&p1){
  const float NEG=-INFINITY;
  #pragma unroll
  for(int r=8;r<16;++r)p0[r]=NEG;
  #pragma unroll
  for(int r=0;r<16;++r)p1[r]=NEG;
}
__device__ __forceinline__ void na_mask(f32x16&p0,f32x16&p1,bool tvalid,int cb,const __attribute__((address_space(3))) float*bl){
  const float NEG=-INFINITY;
  if(!tvalid){
    #pragma unroll
    for(int r=0;r<16;++r){p0[r]=NEG;p1[r]=NEG;}
  }else{
    #pragma unroll
    for(int r=0;r<16;++r){const int k0=(r&3)+8*(r>>2); const float b0=bl[k0],b1=bl[k0+32];
      p0[r]=((unsigned)(k0+cb)<16u)?p0[r]+b0:NEG; p1[r]=((unsigned)(k0+32+cb)<16u)?p1[r]+b1:NEG;}
  }
}

constexpr int NSLOT=3, SLOTB=8192;
constexpr int LDS_K=0, LDS_V=NSLOT*SLOTB, LDS_WS=2*NSLOT*SLOTB, LDS_OST=LDS_WS+NW*64*4, LDS_TAB=LDS_OST+NW*4096, LDS_BYTES=LDS_TAB+2560;
constexpr float C2=0.125f*1.4426950408889634f;
__device__ __forceinline__ void glds16(const void*gsrc,unsigned lds_dst){unsigned keep;
  asm volatile("s_mov_b32 %0, m0\n\ts_mov_b32 m0, %2\n\ts_nop 0\n\tglobal_load_lds_dwordx4 %1, off\n\ts_mov_b32 m0, %0":"=&s"(keep):"v"(gsrc),"s"(lds_dst):"memory");}
__device__ __forceinline__ float max3f(float a,float b,float c){float r;asm("v_max3_f32 %0, %1, %2, %3":"=v"(r):"v"(a),"v"(b),"v"(c));return r;}
__device__ __forceinline__ float max2f(float a,float b){float r;asm("v_max_f32_e32 %0, %1, %2":"=v"(r):"v"(a),"v"(b));return r;}
__device__ __forceinline__ float fadd_s(float a,float b){float r;asm("v_add_f32_e32 %0, %1, %2":"=v"(r):"v"(a),"v"(b));return r;}
__device__ __forceinline__ float fsub_s(float a,float b){float r;asm("v_sub_f32_e32 %0, %1, %2":"=v"(r):"v"(a),"v"(b));return r;}
typedef float f32x2_t __attribute__((ext_vector_type(2))); typedef __bf16 bf16x2_t __attribute__((ext_vector_type(2)));
__device__ __forceinline__ unsigned cvtpk_s(float lo,float hi){f32x2_t v={lo,hi};bf16x2_t b=__builtin_convertvector(v,bf16x2_t);return __builtin_bit_cast(unsigned,b);}
#define WAIT_BAR(N) asm volatile("s_waitcnt vmcnt(" #N ") lgkmcnt(0)\n\ts_barrier":::"memory")

__device__ __forceinline__ void qkt(f32x16&p0,f32x16&p1,const char*Kslot,const bf16x8*qr,const f32x16&negm,int r32,int hi){
  const char*kb=Kslot+hi*1024+r32*16;
  #pragma unroll
  for(int d0=0;d0<4;++d0){
    const bf16x8 b0=*reinterpret_cast<const bf16x8*>(kb+d0*2048);
    const bf16x8 b1=*reinterpret_cast<const bf16x8*>(kb+d0*2048+512);
    if(d0==0){p0=__builtin_amdgcn_mfma_f32_32x32x16_bf16(b0,qr[0],negm,0,0,0);p1=__builtin_amdgcn_mfma_f32_32x32x16_bf16(b1,qr[0],negm,0,0,0);}
    else{p0=__builtin_amdgcn_mfma_f32_32x32x16_bf16(b0,qr[d0],p0,0,0,0);p1=__builtin_amdgcn_mfma_f32_32x32x16_bf16(b1,qr[d0],p1,0,0,0);}}
}
typedef __attribute__((address_space(3))) const char* lds_cptr;
typedef short v4i16_t __attribute__((ext_vector_type(4)));
__device__ __forceinline__ void kload8(bf16x8*kf,lds_cptr kp){
  kf[0]=*(const __attribute__((address_space(3))) bf16x8*)(kp);      kf[1]=*(const __attribute__((address_space(3))) bf16x8*)(kp+512);
  kf[2]=*(const __attribute__((address_space(3))) bf16x8*)(kp+2048); kf[3]=*(const __attribute__((address_space(3))) bf16x8*)(kp+2560);
  kf[4]=*(const __attribute__((address_space(3))) bf16x8*)(kp+4096); kf[5]=*(const __attribute__((address_space(3))) bf16x8*)(kp+4608);
  kf[6]=*(const __attribute__((address_space(3))) bf16x8*)(kp+6144); kf[7]=*(const __attribute__((address_space(3))) bf16x8*)(kp+6656);
}
__device__ __forceinline__ void kload2(bf16x8*kf,lds_cptr kp,int j){ kf[2*j]=*(const __attribute__((address_space(3))) bf16x8*)(kp+j*2048); kf[2*j+1]=*(const __attribute__((address_space(3))) bf16x8*)(kp+j*2048+512); }
__device__ __forceinline__ s16x4 vtr(lds_cptr p){ return __builtin_bit_cast(s16x4,__builtin_amdgcn_ds_read_tr16_b64_v4i16((__attribute__((address_space(3))) v4i16_t*)p)); }
__device__ __forceinline__ float rowmax(const f32x16&p0,const f32x16&p1){
  float a=max3f(p0[0],p0[1],p1[0]),b=max3f(p0[2],p0[3],p1[1]);a=max3f(a,p1[2],p1[3]);
  #pragma unroll
  for(int r=4;r<16;r+=4){a=max3f(a,p0[r],p0[r+1]);b=max3f(b,p0[r+2],p0[r+3]);a=max3f(a,p1[r],p1[r+1]);b=max3f(b,p1[r+2],p1[r+3]);}
  const float m=max2f(a,b);
  auto rr=__builtin_amdgcn_permlane32_swap(__float_as_uint(m),__float_as_uint(m),false,false);
  return max2f(__uint_as_float(rr[0]),__uint_as_float(rr[1]));
}
__device__ __forceinline__ void pv(f32x16*o,int vb,bf16x8 pa0,bf16x8 pa1,bf16x8 pa2,bf16x8 pa3){
  #pragma unroll
  for(int d0=0;d0<2;++d0){s16x4 lo[4],hi[4];
    #pragma unroll
    for(int ks=0;ks<4;++ks){
      asm volatile("ds_read_b64_tr_b16 %0,%1 offset:%c2":"=&v"(lo[ks]):"v"(vb),"i"(d0*4096+ks*1024):"memory");
      asm volatile("ds_read_b64_tr_b16 %0,%1 offset:%c2":"=&v"(hi[ks]):"v"(vb),"i"(d0*4096+ks*1024+512):"memory");}
    asm volatile("s_waitcnt lgkmcnt(0)":::"memory");SBAR();
    #define PK(k) (bf16x8){lo[k][0],lo[k][1],lo[k][2],lo[k][3],hi[k][0],hi[k][1],hi[k][2],hi[k][3]}
    o[d0]=__builtin_amdgcn_mfma_f32_32x32x16_bf16(pa0,PK(0),o[d0],0,0,0);
    o[d0]=__builtin_amdgcn_mfma_f32_32x32x16_bf16(pa1,PK(1),o[d0],0,0,0);
    o[d0]=__builtin_amdgcn_mfma_f32_32x32x16_bf16(pa2,PK(2),o[d0],0,0,0);
    o[d0]=__builtin_amdgcn_mfma_f32_32x32x16_bf16(pa3,PK(3),o[d0],0,0,0);
    #undef PK
  }
}

#ifndef ATTN_STORE16
#define ATTN_STORE16(p,v) (*(u32x4*)(p)=(v))
#endif
struct AttnPtrs { const bf16* Q; const bf16* K; const bf16* V; const bf16* Z; bf16* Zo; const float* rpb; };
template<int THRL,int KIND,int NT> __device__ __forceinline__ void attn_unit(int b,int h,int blk,bool meta,const AttnPtrs&P,char*shm){
  int tid_=threadIdx.x; asm volatile("":"+v"(tid_));
  const int tid=tid_,lane=tid&63,r32=lane&31,hi=lane>>5; const int wid=__builtin_amdgcn_readfirstlane(tid>>6);
  const int wsrc=(KIND==0&&meta)?(wid&1):wid;
  int tok0,hrow0; const int NHK=(KIND==2)?8:2;
  if(KIND==2){ tok0=b*4096+(4*blk+(wid>>1))*64+(wid&1)*32; hrow0=h; }
  else if(!meta){ tok0=b*4096+blk*256+wid*32; hrow0=h; }
  else { tok0=NREAL+b*16; hrow0=4*h+2*wsrc; }
  const bool mrows=(KIND==0&&meta);
  #define ROW_TOK(row) (mrows?tok0+((row)&15):tok0+(row))
  #define ROW_HEAD(row) (mrows?hrow0+((row)>>4):hrow0)
  const int kvh=(KIND==2)?h:(meta?h:(h>>2));
  const bf16*Kh=P.K+(size_t)(b*NHK+kvh)*KVROWS*KVP,*Vh=P.V+(size_t)(b*NHK+kvh)*KVROWS*KVP;
  const int gy0=4*blk, gmin=(KIND==2)?min(max(gy0-4,0),53):0;
  const int qrw=gy0+(wid>>1), rsw=min(max(qrw-4,0),56);
  const int qc=(wid&1)*32+r32, csl=min(max(qc-8,0),48);
  const unsigned lds0=(unsigned)(uintptr_t)shm;
  float*wsf=(float*)(shm+LDS_WS)+wid*64;
  const bf16*ksrc=Kh+(long)lane*KVP+wid*8;
  const bf16*vsrc=Vh+(long)(16*(wid&3)+(lane>>2))*KVP+(wid>>2)*32+(lane&3)*8;
  const unsigned kdst=lds0+LDS_K+wid*1024, vdst=lds0+LDS_V+wid*1024;
  #define TROW(t) ((KIND==2)?(((t)==0)?0:KVBLK*(gmin+(t))):KVBLK*(t))
  #define DMA_K(t,slot) glds16(ksrc+(long)TROW(t)*KVP,(unsigned)__builtin_amdgcn_readfirstlane(kdst+(slot)))
  #define DMA_V(t,slot) glds16(vsrc+(long)TROW(t)*KVP,(unsigned)__builtin_amdgcn_readfirstlane(vdst+(slot)))
  const int vb0=(int)(lds0+LDS_V)+((lane>>4)&1)*32+(lane&3)*8+(4*hi+((lane&15)>>2))*64;
  const char*Kbase=shm+LDS_K; bf16x8 kf[8];
  const lds_cptr shm3=(lds_cptr)shm; const lds_cptr kp0=shm3+LDS_K+hi*1024+r32*16; const lds_cptr vp0=shm3+LDS_V+((lane>>4)&1)*32+(lane&3)*8+(4*hi+((lane&15)>>2))*64;
  DMA_K(0,0);DMA_V(0,0);DMA_K(1,SLOTB);
  bf16x8 qr[4];
  #pragma unroll
  for(int d0=0;d0<4;++d0)qr[d0]=*reinterpret_cast<const bf16x8*>(P.Q+(size_t)ROW_TOK(r32)*512+ROW_HEAD(r32)*64+d0*16+hi*8);
  float mhat=0.f,l_reg=0.f;f32x16 o[2];o[0]=f32x16{};o[1]=f32x16{};f32x16 negm=f32x16{};asm volatile("":"+v"(negm));
  typedef __attribute__((address_space(3))) float lds_f32;
  lds_f32*tab=(lds_f32*)(shm+LDS_TAB);
  if(KIND==2){ for(int i=tid;i<465;i+=NW*64)tab[64+i]=P.rpb[h*465+i]*1.4426950408889634f; }
  const int cbl=4*hi-csl; const lds_f32*bl0=tab+64+15-qc+4*hi;
  #define CMASK(P0,P1,t) do{ if(KIND==2){ const int kr_=gmin+(t)-1; na_mask(P0,P1,(kr_>=rsw)&&(kr_<rsw+8),cbl,bl0+(kr_-qrw+7)*31); } }while(0)
  bool resc=false;
  #define START(P0,P1) do{ const float rm=rowmax(P0,P1); resc=false; \
    { const float dl=rm; mhat=fadd_s(mhat,dl); \
      _Pragma("unroll") for(int r=0;r<16;++r){P0[r]=fsub_s(P0[r],dl);P1[r]=fsub_s(P1[r],dl);} \
      _Pragma("unroll") for(int r=0;r<16;++r)negm[r]=-mhat; asm volatile("":"+v"(negm)); } \
    _Pragma("unroll") for(int r=0;r<16;++r)P0[r]=__builtin_amdgcn_exp2f(P0[r]); }while(0)
  #define RESC() do{ if(resc){ asm volatile("s_waitcnt lgkmcnt(0)":::"memory"); \
      _Pragma("unroll") for(int d_=0;d_<2;++d_) _Pragma("unroll") for(int r=0;r<16;++r)o[d_][r]*=wsf[crow(r,hi)]; } }while(0)
  f32x16 pA0,pA1,pB0,pB1;
  int sl_prev=0,sl_cur=0,sl_next=SLOTB;
  #define ROT() do{sl_prev=sl_cur;sl_cur=sl_next;sl_next=(sl_next==(NSLOT-1)*SLOTB)?0:sl_next+SLOTB;}while(0)
  DMA_K(2,2*SLOTB);
  WAIT_BAR(3);
  qkt(pA0,pA1,Kbase,qr,negm,r32,hi);asm volatile("s_nop 15\n\ts_nop 7":"+v"(pA0),"+v"(pA1));mask_meta(pA0,pA1);
  START(pA0,pA1);
  _Pragma("unroll") for(int r=0;r<16;++r)pA1[r]=__builtin_amdgcn_exp2f(pA1[r]);
  WAIT_BAR(0);
  DMA_K(3,0);DMA_V(1,SLOTB);
  ROT();
  kload8(kf,kp0+sl_cur);
  WAIT_BAR(2);
  s16x4 vlo[8],vhi[8]; u32x4 pw0,pw1,pw2,pw3;
  #define PKW(P,B) cvtpk_s(P[B],P[B+1])
  #define PAF(k) __builtin_bit_cast(bf16x8,pw##k)
  #define VFR(i) (bf16x8){vlo[i][0],vlo[i][1],vlo[i][2],vlo[i][3],vhi[i][0],vhi[i][1],vhi[i][2],vhi[i][3]}
  #define PIN(x) asm volatile("":"+v"(x))
  #define MX3(a,b,c) __builtin_fmaxf(__builtin_fmaxf((a),(b)),(c))
  #define GAPA(MF,A0,A1,A2,A3,W0,W1,PW) do{ MF; sacc+=A0; sacc+=A1; sacc+=A2; sacc+=A3; PIN(sacc); W0; W1; PIN(PW); SBAR(); }while(0)
  #define EX(v) __builtin_amdgcn_exp2f(v)
  #define GAPB(MF,X,B) do{ MF; X[B]=EX(X[B]); X[B+1]=EX(X[B+1]); X[B+2]=EX(X[B+2]); X[B+3]=EX(X[B+3]); PIN(X); SBAR(); }while(0)
  #define VRD(i) do{ vlo[i]=vtr(vp_+(((i)>>2)*4096+((i)&3)*1024)); vhi[i]=vtr(vp_+(((i)>>2)*4096+((i)&3)*1024+512)); }while(0)
  #define KRD(G,j) do{ if(G){ kload2(kf,kp0+sl_next,j); SBAR(); } }while(0)
  #define STEP(C0,C1,P0,P1,t,GK,GV,GL) do{ SBAR(); \
    const lds_cptr vp_=vp0+sl_prev; \
    VRD(0); SBAR(); float sacc=(P0[0]+P0[1]); \
    GAPA(C0=__builtin_amdgcn_mfma_f32_32x32x16_bf16(kf[0],qr[0],negm,0,0,0), P0[2],P0[3],P0[4],P0[5],     pw0[0]=PKW(P0,0), pw0[1]=PKW(P0,2), pw0); \
    VRD(4); SBAR(); GAPA(C1=__builtin_amdgcn_mfma_f32_32x32x16_bf16(kf[1],qr[0],negm,0,0,0), P0[6],P0[7],P0[8],P0[9],     pw0[2]=PKW(P0,4), pw0[3]=PKW(P0,6), pw0); \
    VRD(1); SBAR(); GAPA(C0=__builtin_amdgcn_mfma_f32_32x32x16_bf16(kf[2],qr[1],C0,0,0,0),   P0[10],P0[11],P0[12],P0[13], pw1[0]=PKW(P0,8), pw1[1]=PKW(P0,10), pw1); \
    VRD(5); SBAR(); GAPA(C1=__builtin_amdgcn_mfma_f32_32x32x16_bf16(kf[3],qr[1],C1,0,0,0),   P0[14],P0[15],P1[0],P1[1],   pw1[2]=PKW(P0,12),pw1[3]=PKW(P0,14), pw1); \
    VRD(2); SBAR(); GAPA(C0=__builtin_amdgcn_mfma_f32_32x32x16_bf16(kf[4],qr[2],C0,0,0,0),   P1[2],P1[3],P1[4],P1[5],     pw2[0]=PKW(P1,0), pw2[1]=PKW(P1,2), pw2); \
    VRD(6); SBAR(); GAPA(C1=__builtin_amdgcn_mfma_f32_32x32x16_bf16(kf[5],qr[2],C1,0,0,0),   P1[6],P1[7],P1[8],P1[9],     pw2[2]=PKW(P1,4), pw2[3]=PKW(P1,6), pw2); \
    VRD(3); SBAR(); GAPA(C0=__builtin_amdgcn_mfma_f32_32x32x16_bf16(kf[6],qr[3],C0,0,0,0),   P1[10],P1[11],P1[12],P1[13], pw3[0]=PKW(P1,8), pw3[1]=PKW(P1,10), pw3); \
    VRD(7); SBAR(); GAPA(C1=__builtin_amdgcn_mfma_f32_32x32x16_bf16(kf[7],qr[3],C1,0,0,0),   P1[14],P1[15],0.f,0.f,       pw3[2]=PKW(P1,12),pw3[3]=PKW(P1,14), pw3); \
    l_reg+=sacc; \
    if(GK){DMA_K((t)+3,sl_cur);} if(GV){DMA_V((t)+1,sl_next);} \
    CMASK(C0,C1,t); \
    { float a=MX3(C0[0],C0[1],C1[0]),b=MX3(C0[2],C0[3],C1[1]); a=MX3(a,C1[2],C1[3]); \
      _Pragma("unroll") for(int r=4;r<16;r+=4){a=MX3(a,C0[r],C0[r+1]);b=MX3(b,C0[r+2],C0[r+3]);a=MX3(a,C1[r],C1[r+1]);b=MX3(b,C1[r+2],C1[r+3]);} \
      float rm=__builtin_fmaxf(a,b); { auto rr=__builtin_amdgcn_permlane32_swap(__float_as_uint(rm),__float_as_uint(rm),false,false); rm=__builtin_fmaxf(__uint_as_float(rr[0]),__uint_as_float(rr[1])); } \
      resc=false; \
      if(__builtin_expect(__any(rm>(float)THRL),0)){ const float dl=__builtin_fmaxf(rm,0.f); mhat+=dl; \
        _Pragma("unroll") for(int r=0;r<16;++r){C0[r]-=dl;C1[r]-=dl;} \
        _Pragma("unroll") for(int r=0;r<16;++r)negm[r]=-mhat; asm volatile("":"+v"(negm)); \
        const float f=__builtin_amdgcn_exp2f(-dl); l_reg*=f; if(hi==0)wsf[r32]=f; resc=true; } } \
    SBAR(); \
    GAPB(o[0]=__builtin_amdgcn_mfma_f32_32x32x16_bf16(PAF(0),VFR(0),o[0],0,0,0), C0,0); \
    GAPB(o[1]=__builtin_amdgcn_mfma_f32_32x32x16_bf16(PAF(0),VFR(4),o[1],0,0,0), C0,4); \
    KRD(GL,0); GAPB(o[0]=__builtin_amdgcn_mfma_f32_32x32x16_bf16(PAF(1),VFR(1),o[0],0,0,0), C0,8); \
    KRD(GL,1); GAPB(o[1]=__builtin_amdgcn_mfma_f32_32x32x16_bf16(PAF(1),VFR(5),o[1],0,0,0), C0,12); \
    KRD(GL,2); GAPB(o[0]=__builtin_amdgcn_mfma_f32_32x32x16_bf16(PAF(2),VFR(2),o[0],0,0,0), C1,0); \
    KRD(GL,3); GAPB(o[1]=__builtin_amdgcn_mfma_f32_32x32x16_bf16(PAF(2),VFR(6),o[1],0,0,0), C1,4); \
    GAPB(o[0]=__builtin_amdgcn_mfma_f32_32x32x16_bf16(PAF(3),VFR(3),o[0],0,0,0), C1,8); \
    GAPB(o[1]=__builtin_amdgcn_mfma_f32_32x32x16_bf16(PAF(3),VFR(7),o[1],0,0,0), C1,12); \
    }while(0)
  int t=1;
  for(;t+5<NT;t+=2){
    STEP(pB0,pB1,pA0,pA1,t,true,true,true);     WAIT_BAR(2); RESC(); ROT();
    STEP(pA0,pA1,pB0,pB1,t+1,true,true,true);   WAIT_BAR(2); RESC(); ROT();
  }
  #define ENDW(tt) do{ if((tt)+3<NT){WAIT_BAR(2);} else if((tt)+2<NT){WAIT_BAR(1);} else {WAIT_BAR(0);} }while(0)
  for(;t+1<NT;t+=2){
    STEP(pB0,pB1,pA0,pA1,t,(t+3<NT),(t+1<NT),(t+1<NT));       ENDW(t);   RESC(); ROT();
    STEP(pA0,pA1,pB0,pB1,t+1,(t+4<NT),(t+2<NT),(t+2<NT));     ENDW(t+1); RESC(); ROT();
  }
  #define DRAIN(PX0,PX1,SLOT) do{ float sacc=PX0[0]+PX0[1]; _Pragma("unroll") for(int r=2;r<16;++r)sacc+=PX0[r]; _Pragma("unroll") for(int r=0;r<16;++r)sacc+=PX1[r]; l_reg+=sacc; \
    pw0=(u32x4){PKW(PX0,0),PKW(PX0,2),PKW(PX0,4),PKW(PX0,6)};pw1=(u32x4){PKW(PX0,8),PKW(PX0,10),PKW(PX0,12),PKW(PX0,14)};pw2=(u32x4){PKW(PX1,0),PKW(PX1,2),PKW(PX1,4),PKW(PX1,6)};pw3=(u32x4){PKW(PX1,8),PKW(PX1,10),PKW(PX1,12),PKW(PX1,14)}; \
    SBAR(); pv(o,vb0+(SLOT),PAF(0),PAF(1),PAF(2),PAF(3)); }while(0)
  if constexpr((NT&1)==0){ STEP(pB0,pB1,pA0,pA1,NT-1,false,false,false); RESC(); DRAIN(pB0,pB1,sl_cur); }
  else { DRAIN(pA0,pA1,sl_prev); }
  #undef DRAIN
  #undef PKW
  #undef PAF
  #undef VFR
  #undef PIN
  #undef MX3
  #undef GAPA
  #undef GAPB
  #undef EX
  #undef VRD
  #undef KRD
  #undef STEP
  #undef ENDW
  {auto rr=__builtin_amdgcn_permlane32_swap(__float_as_uint(l_reg),__float_as_uint(l_reg),false,false);l_reg=__uint_as_float(rr[0])+__uint_as_float(rr[1]);}
  if(hi==0)wsf[32+r32]=l_reg;asm volatile("s_waitcnt lgkmcnt(0)":::"memory");
  float rli[16];
  #pragma unroll
  for(int r=0;r<16;++r)rli[r]=__builtin_amdgcn_rcpf(wsf[32+crow(r,hi)]);
  { bf16*stg=(bf16*)(shm+LDS_OST)+wid*2048;
    #pragma unroll
    for(int r=0;r<16;++r){const int orow=crow(r,hi);
      #pragma unroll
      for(int d0=0;d0<2;++d0)stg[orow*64+d0*32+r32]=__float2bfloat16(o[d0][r]*rli[r]);}
    asm volatile("s_waitcnt lgkmcnt(0)":::"memory");
    const bool dostore=!(KIND==0&&meta)||wid<2;
    #pragma unroll
    for(int i=0;i<4;++i){const int row=i*8+(lane>>3),ch=lane&7; const u32x4 v=*(const u32x4*)(stg+row*64+ch*8);
      const size_t zo_=(size_t)ROW_TOK(row)*1024+ROW_HEAD(row)*64+ch*8; const u32x4 z=*(const u32x4*)(P.Z+zo_); u32x4 w;
      #pragma unroll
      for(int q=0;q<4;++q) w[q]=cvtpk_s(__uint_as_float(v[q]<<16)*__uint_as_float(z[q]<<16),__uint_as_float(v[q]&0xffff0000u)*__uint_as_float(z[q]&0xffff0000u));
      if(dostore)*(u32x4*)(P.Zo+zo_)=w; } }
  asm volatile("s_waitcnt lgkmcnt(0)\n\ts_barrier":::"memory");
  #undef DMA_K
  #undef DMA_V
  #undef TROW
  #undef ROW_TOK
  #undef ROW_HEAD
  #undef CMASK
  #undef START
  #undef RESC
  #undef ROT
}
constexpr int ATTN_LDS_BYTES=LDS_BYTES;
#undef SBAR
#undef WAIT_BAR
}

#define GAS __attribute__((address_space(1)))
#define LAS __attribute__((address_space(3)))
typedef GAS unsigned gu32;
#define RLX_AGENT __ATOMIC_RELAXED, __HIP_MEMORY_SCOPE_AGENT
#define LDS_WAIT() asm volatile("s_waitcnt lgkmcnt(0)" ::: "memory")
#define VM_WAIT() asm volatile("s_waitcnt vmcnt(0)" ::: "memory")
#define XB_TMO      128
#define XB_XCNT(j)  (256  + 64 * (j))
#define XB_XSUB(j)  (1280 + 64 * (j))
#define XB_XGEN(j)  (2304 + 64 * (j))
#define XB_TOP      3328
#define XB_TOPGEN   3392
#define XCD_BAR_WORDS 3456
#define XB_SPIN_CAP (1u << 18)

__device__ __forceinline__ unsigned xb_ld(unsigned* p)              { return __hip_atomic_load(p, __ATOMIC_RELAXED, __HIP_MEMORY_SCOPE_AGENT); }
__device__ __forceinline__ unsigned xb_add(unsigned* p, unsigned v) { return __hip_atomic_fetch_add(p, v, __ATOMIC_RELAXED, __HIP_MEMORY_SCOPE_AGENT); }
__device__ __forceinline__ unsigned xb_xcc_id() { return (unsigned)__builtin_amdgcn_s_getreg((3 << 11) | 20) & 0xFu; }
#define XB_SPIN(cond, bar) do { unsigned _sp = 0; while (cond) { __builtin_amdgcn_s_sleep(1); \
    if ((++_sp & 255u) == 0u) { if (xb_ld(&(bar)[XB_TMO])) break; if (_sp > XB_SPIN_CAP) { atomicAdd(&(bar)[XB_TMO], 1u); break; } } } } while (0)

struct XcdBarrier {
    unsigned* bar; unsigned x;
    volatile LAS unsigned* st;
};

__device__ __forceinline__ XcdBarrier xcd_barrier_post(unsigned* bar, volatile LAS unsigned* st) {
    XcdBarrier b; b.bar = bar; b.x = xb_xcc_id(); b.st = st;
    if (threadIdx.x == 0) (void)xb_add(&bar[XB_XCNT(b.x)], 1u);
    return b;
}
__device__ __forceinline__ void xcd_barrier_complete(unsigned* bar, unsigned x, unsigned& nloc, unsigned& nx) {
    const unsigned G = gridDim.x * gridDim.y * gridDim.z;
    unsigned sum, cnt, mine, sp = 0u;
    for (;;) {
        sum = 0u; cnt = 0u; mine = 0u;
#pragma unroll
        for (unsigned j = 0; j < 16; ++j) { const unsigned c = xb_ld(&bar[XB_XCNT(j)]); sum += c; cnt += (c > 0u) ? 1u : 0u; mine = (j == x) ? c : mine; }
        if (sum == G) break;
        __builtin_amdgcn_s_sleep(1);
        if ((++sp & 255u) == 0u) { if (xb_ld(&bar[XB_TMO])) break; if (sp > XB_SPIN_CAP) { atomicAdd(&bar[XB_TMO], 1u); break; } }
    }
    nloc = mine > 0u ? mine : 1u; nx = cnt > 0u ? cnt : 1u;
}

__device__ __forceinline__ void xcd_barrier(const XcdBarrier& b) {
    asm volatile("s_waitcnt vmcnt(0)" ::: "memory");
    __syncthreads();
    if (threadIdx.x == 0) {
        unsigned* bar = b.bar;
        __builtin_amdgcn_s_waitcnt(0);
        unsigned nloc = b.st[0], nx = b.st[1];
        if (nloc == 0u) { xcd_barrier_complete(bar, b.x, nloc, nx); b.st[0] = nloc; b.st[1] = nx; }
        const unsigned old = xb_add(&bar[XB_XSUB(b.x)], 1u);
        const unsigned gen = old / nloc;
        if (old + 1u == (gen + 1u) * nloc) {
            __builtin_amdgcn_fence(__ATOMIC_RELEASE, "agent");
            asm volatile("s_waitcnt vmcnt(0)" ::: "memory");
            const unsigned og = xb_add(&bar[XB_TOP], 1u);
            const unsigned tg = og / nx;
            if (og + 1u == (tg + 1u) * nx) xb_add(&bar[XB_TOPGEN], 1u);
            else XB_SPIN(xb_ld(&bar[XB_TOPGEN]) == tg, bar);
            __builtin_amdgcn_fence(__ATOMIC_ACQUIRE, "agent");
            xb_add(&bar[XB_XGEN(b.x)], 1u);
            asm volatile("s_waitcnt vmcnt(0)" ::: "memory");
        } else {
            XB_SPIN(xb_ld(&bar[XB_XGEN(b.x)]) == gen, bar);
            __builtin_amdgcn_fence(__ATOMIC_ACQUIRE, "agent");
            asm volatile("s_waitcnt vmcnt(0)" ::: "memory");
        }
    }
    __syncthreads();
}

constexpr int NWAVES = 8;
constexpr int RING_BYTES = 131072, LDSCTL_OFF = RING_BYTES, MISC_OFF = LDSCTL_OFF + 320, LDS_BYTES = 147456;
constexpr int CW_BAR = 4096;
constexpr size_t CTL_ZERO_BYTES = 1 * MiB;
constexpr int N_PHASES = 10;
static_assert(attn_body::ATTN_LDS_BYTES <= RING_BYTES, "attention scratch fits the ring region");
static_assert((CW_BAR + N_PHASES * XCD_BAR_WORDS) * 4 <= (int)CTL_ZERO_BYTES, "barrier words inside the memset block");

#ifndef PROBE_DUP
#define PROBE_DUP 0
#endif
struct MkArgs { const float* in[11]; float* out; unsigned char* ws; int ph_lo, ph_hi, li, pad; };

__device__ __forceinline__ int head_slot(int cw) { const int wc = cw >> 6, d = cw & 63; return 128 * ((d >> 4) & 1) + 32 * wc + 16 * ((d >> 2) & 1) + 8 * (d >> 5) + 4 * ((d >> 3) & 1) + (d & 3); }
__device__ __forceinline__ int elem_slot(int cw) { const int e = cw & 31; return (cw & ~31) + 16 * ((e >> 2) & 1) + 4 * (e >> 3) + (e & 3); }
__device__ __forceinline__ int in_slot(int ncol) { const int t = ncol >> 8, cw = ncol & 255; const bool head = (t < 3) || (t >= 5 && t < 11); return t * 256 + (head ? head_slot(cw) : elem_slot(cw)); }

template <bool INMAP> __device__ __forceinline__ void p0_transpose_item(const float* W, int K, int N, bf16_t* WT, int ldk, int koff, LAS float* scr, int item, int lane) {
    const int nblk = N / 32, kb = item / nblk, nb = item % nblk, k0 = 64 * kb, n0 = 32 * nb;
#pragma unroll 8
    for (int i = 0; i < 32; ++i) { const int kk = 2 * i + (lane >> 5); scr[kk * 33 + (lane & 31)] = W[(size_t)(k0 + kk) * N + n0 + (lane & 31)]; }
    LDS_WAIT(); asm volatile("" ::: "memory");
    const int c = lane & 7;
#pragma unroll
    for (int j = 0; j < 4; ++j) { const int n = (lane >> 3) + 8 * j; const LAS float* s = scr + (8 * c) * 33 + n;
        u32x4 o; o.x = pk2(s[0 * 33], s[1 * 33]); o.y = pk2(s[2 * 33], s[3 * 33]); o.z = pk2(s[4 * 33], s[5 * 33]); o.w = pk2(s[6 * 33], s[7 * 33]);
        const int nc = n0 + n, row = INMAP ? in_slot(nc) : ((nc & ~255) + elem_slot(nc & 255));
        *(u32x4*)(WT + (size_t)row * ldk + koff + k0 + 8 * c) = o; }
    LDS_WAIT(); asm volatile("" ::: "memory");
}

struct Ptrs {
    const float *x, *meta, *norm_g, *w_in, *qng, *kng, *rpb, *w_oa, *w_ob, *w_out, *fin_g; float* out;
    float *rope, *HM, *rowp; bf16_t *WinP, *WoC, *WoutP, *XN, *QA, *QB, *MIX, *Z, *KA, *VA, *KB, *VB, *GA, *GB;
};
__device__ __forceinline__ void p0_prologue(const Ptrs& P, LAS unsigned char* lds, int vcu, int G, int wave, int lane) {
    LAS float* scr = (LAS float*)(lds + wave * 16384);
    const int gw = vcu * NWAVES + wave, NGW = G * NWAVES;
    constexpr int I_IN = (DM / 64) * (INC / 32), I_O = (512 / 64) * (DM / 32), I_OUT = (DM / 64) * (DM / 32), I_L = I_IN + 2 * I_O + I_OUT;
    for (int it = gw; it < 2 * I_L; it += NGW) {
        const int l = it / I_L; int r = it % I_L;
        if (r < I_IN) { p0_transpose_item<true>(P.w_in + (size_t)l * DM * INC, DM, INC, P.WinP + (size_t)l * INC * DM, DM, 0, scr, r, lane); continue; } r -= I_IN;
        if (r < I_O) { p0_transpose_item<false>(P.w_oa + (size_t)l * 512 * DM, 512, DM, P.WoC + (size_t)l * DM * DM, DM, 0, scr, r, lane); continue; } r -= I_O;
        if (r < I_O) { p0_transpose_item<false>(P.w_ob + (size_t)l * 512 * DM, 512, DM, P.WoC + (size_t)l * DM * DM, DM, 512, scr, r, lane); continue; } r -= I_O;
        p0_transpose_item<false>(P.w_out + (size_t)l * DM * DM, DM, DM, P.WoutP + (size_t)l * DM * DM, DM, 0, scr, r, lane);
    }
    for (int r = gw; r < NTOK; r += NGW) {
        const float* src = (r < NREAL) ? P.x + (size_t)r * DM : P.meta + (size_t)((r - NREAL) & 15) * DM;
        float ss = 0.f; f32x4 v[4];
#pragma unroll
        for (int j = 0; j < 4; ++j) { v[j] = *(const f32x4*)(src + 256 * j + 4 * lane); ss += (v[j].x * v[j].x + v[j].y * v[j].y) + (v[j].z * v[j].z + v[j].w * v[j].w); }
        ss = wave_sum(ss);
#pragma unroll
        for (int j = 0; j < 4; ++j) { const f32x4 gg = *(const f32x4*)(P.norm_g + 256 * j + 4 * lane); u32x2 o; o.x = pk2(v[j].x * gg.x, v[j].y * gg.y); o.y = pk2(v[j].z * gg.z, v[j].w * gg.w); *(u32x2*)(P.XN + (size_t)r * DM + 256 * j + 4 * lane) = o; }
        if (lane < 16) P.rowp[(size_t)r * 16 + lane] = lane ? 0.f : ss;
    }
    const int gt = gw * 64 + lane, nt = NGW * 64;
    for (int i = gt; i < 64 * 16; i += nt) { const int pos = i >> 4, k = i & 15; const float inv = powf(10000.f, -(float)k / 16.f); const float a = (float)pos * inv; P.rope[i] = cosf(a); P.rope[1024 + i] = sinf(a); }
    for (int i = gt; i < NB * 2 * 3072; i += nt) { const int hh = i / 3072, e = i % 3072; P.KA[(size_t)hh * KVROWS * 64 + 1024 + e] = 0; P.VA[(size_t)hh * KVROWS * 64 + 1024 + e] = 0; }
    for (int i = gt; i < NB * 8 * 3072; i += nt) { const int hh = i / 3072, e = i % 3072; P.KB[(size_t)hh * KVROWS * 64 + 1024 + e] = 0; P.VB[(size_t)hh * KVROWS * 64 + 1024 + e] = 0; }
    for (int i = gt; i < (MPAD - NTOK) * 1024; i += nt) { P.XN[(size_t)NTOK * 1024 + i] = 0; P.Z[(size_t)NTOK * 1024 + i] = 0; }
    for (int i = gt; i < 3 * (MPAD - NTOK) * 16; i += nt) { const int st = i / ((MPAD - NTOK) * 16), e = i % ((MPAD - NTOK) * 16); P.rowp[((size_t)st * MPAD + NTOK) * 16 + e] = (e & 15) ? 0.f : 1024.f; }
}

__device__ __forceinline__ void na_meta_wave(int b, int h, const Ptrs& P, int lane) {
    const int q = lane & 15, dq = lane >> 4, tok = NREAL + b * 16 + q;
    float qv[16], o[16], s[16];
    { const bf16_t* qp = P.QB + (size_t)tok * 512 + h * 64 + 16 * dq;
#pragma unroll
      for (int c = 0; c < 2; ++c) { const u32x4 v = *(const u32x4*)(qp + 8 * c);
#pragma unroll
        for (int e = 0; e < 4; ++e) { qv[8 * c + 2 * e] = bf2f(v[e] & 0xffff); qv[8 * c + 2 * e + 1] = bf2f(v[e] >> 16); } } }
    const bf16_t* Kh = P.KB + (size_t)(b * 8 + h) * KVROWS * 64 + 16 * dq; const bf16_t* Vh = P.VB + (size_t)(b * 8 + h) * KVROWS * 64 + 16 * dq;
    float mx = -INFINITY;
#pragma unroll
    for (int j = 0; j < 16; ++j) { float acc = 0.f;
#pragma unroll
        for (int c = 0; c < 2; ++c) { const u32x4 v = *(const u32x4*)(Kh + j * 64 + 8 * c);
#pragma unroll
            for (int e = 0; e < 4; ++e) acc += qv[8 * c + 2 * e] * bf2f(v[e] & 0xffff) + qv[8 * c + 2 * e + 1] * bf2f(v[e] >> 16); }
        acc += __shfl_xor(acc, 16); acc += __shfl_xor(acc, 32); s[j] = acc; mx = fmaxf(mx, acc); }
    float l = 0.f;
#pragma unroll
    for (int i = 0; i < 16; ++i) o[i] = 0.f;
#pragma unroll
    for (int j = 0; j < 16; ++j) { const float p = exp2f(s[j] - mx); l += p;
#pragma unroll
        for (int c = 0; c < 2; ++c) { const u32x4 v = *(const u32x4*)(Vh + j * 64 + 8 * c);
#pragma unroll
            for (int e = 0; e < 4; ++e) { o[8 * c + 2 * e] += p * bf2f(v[e] & 0xffff); o[8 * c + 2 * e + 1] += p * bf2f(v[e] >> 16); } } }
    const float inv = 1.f / l; bf16_t* zp = P.Z + (size_t)tok * 1024 + 512 + h * 64 + 16 * dq;
#pragma unroll
    for (int c = 0; c < 2; ++c) { const u32x4 z = *(const u32x4*)(zp + 8 * c); u32x4 w;
#pragma unroll
        for (int e = 0; e < 4; ++e) w[e] = pk2(o[8 * c + 2 * e] * inv * bf2f(z[e] & 0xffff), o[8 * c + 2 * e + 1] * inv * bf2f(z[e] >> 16));
        *(u32x4*)(zp + 8 * c) = w; }
}

__device__ __forceinline__ f32x4 skinny_acc(const bf16_t* __restrict__ A, const bf16_t* __restrict__ B, int K) {
    f32x4 acc = {0.f, 0.f, 0.f, 0.f};
#pragma unroll 1
    for (int k0 = 0; k0 < K; k0 += 256) {
        bf16x8 a[8], b[8];
#pragma unroll
        for (int i = 0; i < 8; ++i) { a[i] = *(const bf16x8*)(A + k0 + 32 * i); b[i] = *(const bf16x8*)(B + k0 + 32 * i); }
#pragma unroll
        for (int i = 0; i < 8; ++i) acc = __builtin_amdgcn_mfma_f32_16x16x32_bf16(b[i], a[i], acc, 0, 0, 0);
    }
    return acc;
}
__device__ __forceinline__ void skinny_mix(const Ptrs& P, int vcu, int wave, int lane) {
    if (vcu >= 128 || wave >= 4) return;
    const int fr = lane & 15, fq = lane >> 4, r = NREAL + 16 * (vcu >> 4) + fr, c0 = 64 * (vcu & 15) + 16 * wave, c = c0 + fr;
    const bf16_t* Ar = P.Z + (size_t)r * 1024 + 8 * fq; const bf16_t* Br = P.WoC + (size_t)((c & ~255) + elem_slot(c & 255)) * 1024 + 8 * fq;
    const f32x4 a1 = skinny_acc(Ar, Br, 512), a2 = skinny_acc(Ar + 512, Br + 512, 512);
    const size_t off = (size_t)r * 1024 + c0 + 4 * fq;
    const u32x2 ga = *(const u32x2*)(P.GA + off), gb = *(const u32x2*)(P.GB + off);
    u32x2 o; o.x = pk2(bf2f(ga.x & 0xffff) * a1[0] + bf2f(gb.x & 0xffff) * a2[0], bf2f(ga.x >> 16) * a1[1] + bf2f(gb.x >> 16) * a2[1]);
    o.y = pk2(bf2f(ga.y & 0xffff) * a1[2] + bf2f(gb.y & 0xffff) * a2[2], bf2f(ga.y >> 16) * a1[3] + bf2f(gb.y >> 16) * a2[3]);
    *(u32x2*)(P.MIX + off) = o;
}
__device__ __forceinline__ void skinny_out(const Ptrs& P, int vcu, int wave, int lane, LAS float* part) {
    if (vcu < 128 && wave < 4) {
        const int fr = lane & 15, fq = lane >> 4, r = NREAL + 16 * (vcu >> 4) + fr, c0 = 64 * (vcu & 15) + 16 * wave, c = c0 + fr, cc = c0 + 4 * fq;
        const bf16_t* Ar = P.MIX + (size_t)r * 1024 + 8 * fq; const bf16_t* Br = P.WoutP + (size_t)((c & ~255) + elem_slot(c & 255)) * 1024 + 8 * fq;
        const f32x4 acc = skinny_acc(Ar, Br, 1024);
        const f32x4 h = *(const f32x4*)(P.meta + (size_t)((r - NREAL) & 15) * DM + cc) + acc;
        *(f32x4*)(P.HM + (size_t)(r - NREAL) * DM + cc) = h;
        const f32x4 g = *(const f32x4*)(P.norm_g + DM + cc);
        u32x2 o; o.x = pk2(h[0] * g[0], h[1] * g[1]); o.y = pk2(h[2] * g[2], h[3] * g[3]); *(u32x2*)(P.XN + (size_t)r * DM + cc) = o;
        float ss = (h[0] * h[0] + h[1] * h[1]) + (h[2] * h[2] + h[3] * h[3]); ss += __shfl_xor(ss, 16); ss += __shfl_xor(ss, 32);
        if (fq == 0) part[wave * 16 + fr] = ss;
    }
    __syncthreads();
    if (vcu < 128 && wave == 0 && lane < 16) P.rowp[((size_t)MPAD + NREAL + 16 * (vcu >> 4) + lane) * 16 + (vcu & 15)] = (part[lane] + part[16 + lane]) + (part[32 + lane] + part[48 + lane]);
    __syncthreads();
}

typedef const __attribute__((address_space(4))) MkArgs* KArgP;
__device__ __forceinline__ KArgP kargs() { KArgP p = (KArgP)__builtin_amdgcn_kernarg_segment_ptr(); asm volatile("" : "+s"(p)); return p; }
__device__ __forceinline__ Ptrs make_ptrs() {
    KArgP a = kargs(); Ptrs P; unsigned char* ws = a->ws;
    P.x = a->in[0]; P.meta = a->in[1]; P.norm_g = a->in[2]; P.w_in = a->in[3]; P.qng = a->in[4]; P.kng = a->in[5]; P.rpb = a->in[6];
    P.w_oa = a->in[7]; P.w_ob = a->in[8]; P.w_out = a->in[9]; P.fin_g = a->in[10]; P.out = a->out;
    P.rope = (float*)(ws + WS_ROPE); P.HM = (float*)(ws + WS_HM); P.rowp = (float*)(ws + WS_ROWP);
    P.WinP = (bf16_t*)(ws + WS_WIN_P); P.WoC = (bf16_t*)(ws + WS_WOC); P.WoutP = (bf16_t*)(ws + WS_WOUT_P); P.XN = (bf16_t*)(ws + WS_XN);
    P.QA = (bf16_t*)(ws + WS_QA); P.QB = (bf16_t*)(ws + WS_QB); P.MIX = (bf16_t*)(ws + WS_MIX); P.Z = (bf16_t*)(ws + WS_Z);
    P.KA = (bf16_t*)(ws + WS_KA); P.VA = (bf16_t*)(ws + WS_VA); P.KB = (bf16_t*)(ws + WS_KB); P.VB = (bf16_t*)(ws + WS_VB); P.GA = (bf16_t*)(ws + WS_GA); P.GB = (bf16_t*)(ws + WS_GB);
    return P;
}
__global__ void __launch_bounds__(NWAVES * 64, 2) mk_fwd(MkArgs args) {
    extern __shared__ __attribute__((aligned(16))) unsigned char lds[];
    LAS unsigned char* L = (LAS unsigned char*)lds;
    volatile LAS unsigned* MISC = (volatile LAS unsigned*)(L + MISC_OFF);
    const int tid = threadIdx.x;
    const int G = gridDim.x; const int bx = blockIdx.x;
    const int vcu_ = (G % 8 == 0) ? (bx % 8) * (G / 8) + bx / 8 : bx;
#define VCU vcu_
#define WAVE (__builtin_amdgcn_readfirstlane((int)threadIdx.x >> 6))
#define LANE ([]() __attribute__((always_inline)) { int t_ = threadIdx.x; asm volatile("" : "+v"(t_)); return t_ & 63; }())
    for (int u = tid; u < (LDS_BYTES - LDSCTL_OFF) / 4; u += NWAVES * 64) ((LAS unsigned*)(L + LDSCTL_OFF))[u] = 0u;
    __syncthreads();
    XcdBarrier bar = xcd_barrier_post((unsigned*)(args.ws + WS_CTL) + CW_BAR + args.li * XCD_BAR_WORDS, MISC + 8);
    const int lo = args.ph_lo, hi = args.ph_hi;
#define IN(k) (lo <= (k) && (k) < hi)
#define SEAM(k) do { if (IN(k) && IN((k) + 1)) xcd_barrier(bar); } while (0)

    if (IN(0)) { const Ptrs P = make_ptrs(); p0_prologue(P, L, VCU, G, WAVE, LANE); SEAM(0); }

#pragma unroll 1
    for (int l = 0; l < 2; ++l) {
        const int pb = 1 + 4 * l;
        if (IN(pb)) {
            const Ptrs P = make_ptrs();
            pg8::Gemm g{P.XN, P.WinP + (size_t)l * INC * DM, MPAD, INC, DM}; pg8::StaticOrder S; S.init(MPAD, INC, G, bx);
            pg8::EpiIn E{P.rowp + (size_t)l * MPAD * 16, P.qng + l * 64, P.kng + l * 64, P.rope, P.QA, P.KA, P.VA, P.Z, P.QB, P.KB, P.VB, P.GA, P.GB};
#pragma unroll 1
            for (int rep = ((PROBE_DUP & 1) && l == 0) ? 0 : 1; rep < 2; ++rep) { if (rep == 0) { int z_ = 0; asm volatile("" : "+s"(z_)); } pg8::gemm_phase<pg8::EpiIn, pg8::StaticOrder, true, true>(L, g, S, E); if (rep == 0) xcd_barrier(bar); }
            SEAM(pb);
        }
        if (IN(pb + 1)) {
            { const Ptrs P = make_ptrs(); const int vcu = VCU;
              attn_body::AttnPtrs PA{(const attn_body::bf16*)P.QA, (const attn_body::bf16*)P.KA, (const attn_body::bf16*)P.VA, (const attn_body::bf16*)P.Z, (attn_body::bf16*)P.Z, nullptr};
              const int nun = (l == 0 && vcu < 16) ? 5 : 4;
              const int ndup = ((PROBE_DUP & 2) && l == 1) ? 4 : 0;
#pragma unroll 1
              for (int ii = 0; ii < nun + ndup; ++ii) {
                const int i = ii < ndup ? ii : ii - ndup; PA.Zo = (attn_body::bf16*)(ii < ndup ? P.XN : P.Z);
                const bool meta = i == 4; const int pair = meta ? vcu : (vcu >> 4), qb = vcu & 15;
                attn_body::attn_unit<8, 0, 65>(pair >> 1, meta ? (pair & 1) : 4 * (pair & 1) + i, qb, meta, PA, (char*)lds);
              } }
            { const Ptrs P = make_ptrs(); const int vcu = VCU;
              attn_body::AttnPtrs PB{(const attn_body::bf16*)P.QB, (const attn_body::bf16*)P.KB, (const attn_body::bf16*)P.VB, (const attn_body::bf16*)(P.Z + 512), (attn_body::bf16*)(P.Z + 512), P.rpb + (size_t)l * 8 * 465};
              const int ndupb = ((PROBE_DUP & 4) && l == 1) ? 4 : 0;
              const int nb = (l == 0) ? (vcu < 16 ? 2 : (vcu < 48 ? 5 : 4)) : 4;
#pragma unroll 1
              for (int ii = 0; ii < nb + ndupb; ++ii) {
                const int i2 = ii < ndupb ? ii : ii - ndupb; PB.Zo = (attn_body::bf16*)(ii < ndupb ? P.XN + 512 : P.Z + 512);
                const int u = (i2 < 4) ? vcu + 256 * i2 : ((vcu - 16) >> 1) + 256 * (2 + ((vcu - 16) & 1));
                const int bh = (u & 255) >> 2, blk = 4 * (u & 3) + (u >> 8);
                attn_body::attn_unit<8, 2, 12>(bh >> 3, bh & 7, blk, false, PB, (char*)lds);
              }
              if (l == 0) { const int ln = LANE; for (int u = vcu * NWAVES + WAVE; u < 64; u += G * NWAVES) na_meta_wave(u >> 3, u & 7, P, ln); } }
            SEAM(pb + 1);
        }
        if (IN(pb + 2)) {
            const Ptrs P = make_ptrs();
            if (l == 0) skinny_mix(P, VCU, WAVE, LANE);
            pg8::Gemm g{P.Z, P.WoC + (size_t)l * DM * DM, NREAL, DM, DM}; pg8::StaticOrder S; S.init(NREAL, DM, G, bx);
            pg8::EpiMix E{P.GA, P.GB, P.MIX};
#pragma unroll 1
            for (int rep = ((PROBE_DUP & 8) && l == 0) ? 0 : 1; rep < 2; ++rep) { if (rep == 0) { int z_ = 0; asm volatile("" : "+s"(z_)); } pg8::gemm_phase<pg8::EpiMix, pg8::StaticOrder, true, true>(L, g, S, E); if (rep == 0) xcd_barrier(bar); }
            SEAM(pb + 2);
        }
        if (IN(pb + 3)) {
            const Ptrs P = make_ptrs();
            if (l == 0) skinny_out(P, VCU, WAVE, LANE, (LAS float*)(L + LDSCTL_OFF));
            pg8::Gemm g{P.MIX, P.WoutP + (size_t)l * DM * DM, NREAL, DM, DM}; pg8::StaticOrder S; S.init(NREAL, DM, G, bx);
            pg8::EpiOut E;
            if (l == 0) E = pg8::EpiOut{P.x, P.out, P.norm_g + DM, P.XN, P.rowp + (size_t)1 * MPAD * 16};
            else E = pg8::EpiOut{P.out, P.out, nullptr, nullptr, P.rowp + (size_t)2 * MPAD * 16};
#pragma unroll 1
            for (int rep = ((PROBE_DUP & 8) && l == 0) ? 0 : 1; rep < 2; ++rep) { if (rep == 0) { int z_ = 0; asm volatile("" : "+s"(z_)); } pg8::gemm_phase<pg8::EpiOut, pg8::StaticOrder, true, true>(L, g, S, E); if (rep == 0) xcd_barrier(bar); }
            SEAM(pb + 3);
        }
    }
    if (IN(9)) {
        const Ptrs P = make_ptrs(); const int lane = LANE;
        const float* rp = P.rowp + (size_t)2 * MPAD * 16;
        for (int r = VCU * NWAVES + WAVE; r < NREAL; r += G * NWAVES) {
            const float rstd = pg8::rowp_rstd(rp, r); float* p = P.out + (size_t)r * DM;
#pragma unroll
            for (int j = 0; j < 4; ++j) { const f32x4 v = *(const f32x4*)(p + 256 * j + 4 * lane), gg = *(const f32x4*)(P.fin_g + 256 * j + 4 * lane); *(f32x4*)(p + 256 * j + 4 * lane) = v * rstd * gg; }
        }
    }
#undef IN
#undef SEAM
#undef VCU
#undef WAVE
#undef LANE
}

#ifndef OPT_MASK
#define OPT_MASK 0x3FF
#endif
#ifndef FORCE_HYBRID
#define FORCE_HYBRID 0
#endif
extern "C" void kernel_launch(void* const* d_in, const int* in_sizes, int n_in, void* d_out, int out_size, void* d_ws, size_t ws_size, hipStream_t stream) {
    static int grid = 0;
    if (grid == 0) {
        if (n_in != 11 || ws_size < WS_END || out_size != NREAL * DM) { fprintf(stderr, "kernel_launch: unexpected shapes (n_in %d, ws %zu, out %d)\n", n_in, ws_size, out_size); grid = -1; return; }
        int dev = 0, cus = 0, per_cu = 0;
        if (hipGetDevice(&dev) != hipSuccess || hipDeviceGetAttribute(&cus, hipDeviceAttributeMultiprocessorCount, dev) != hipSuccess) { grid = -1; return; }
        if (hipFuncSetAttribute((const void*)mk_fwd, hipFuncAttributeMaxDynamicSharedMemorySize, LDS_BYTES) != hipSuccess) { fprintf(stderr, "kernel_launch: hipFuncSetAttribute failed\n"); grid = -1; return; }
        if (hipOccupancyMaxActiveBlocksPerMultiprocessor(&per_cu, (const void*)mk_fwd, NWAVES * 64, LDS_BYTES) != hipSuccess || per_cu < 1) { fprintf(stderr, "kernel_launch: occupancy query says %d blocks per CU\n", per_cu); (void)hipGetLastError(); }
        if (cus < 256) { fprintf(stderr, "kernel_launch: %d CUs, need 256\n", cus); grid = -1; return; }
        grid = 256;
    }
    if (grid < 0) return;
    const float* x = (const float*)d_in[0]; const float* meta = (const float*)d_in[1]; const float* norm_g = (const float*)d_in[2]; const float* w_in = (const float*)d_in[3];
    const float* qng = (const float*)d_in[4]; const float* kng = (const float*)d_in[5]; const float* rpb = (const float*)d_in[6];
    const float* w_oa = (const float*)d_in[7]; const float* w_ob = (const float*)d_in[8]; const float* w_out = (const float*)d_in[9]; const float* fin_g = (const float*)d_in[10];
    unsigned char* ws = (unsigned char*)d_ws; float* out = (float*)d_out;
    (void)hipMemsetAsync(ws + WS_CTL, 0, CTL_ZERO_BYTES, stream);
    MkArgs a{};
    for (int i = 0; i < 11; ++i) a.in[i] = (const float*)d_in[i];
    a.out = out; a.ws = ws;
    if (OPT_MASK == 0x3FF && !FORCE_HYBRID) {
        a.ph_lo = 0; a.ph_hi = N_PHASES; a.li = 0;
        hipLaunchKernelGGL(mk_fwd, dim3(grid), dim3(NWAVES * 64), LDS_BYTES, stream, a);
        return;
    }
    float* rowp = (float*)(ws + WS_ROWP); float* rope = (float*)(ws + WS_ROPE); float* HM = (float*)(ws + WS_HM);
    bf16_t* WinN = (bf16_t*)(ws + WS_WIN_N); bf16_t* WoA = (bf16_t*)(ws + WS_WOA); bf16_t* WoB = (bf16_t*)(ws + WS_WOB); bf16_t* Wout = (bf16_t*)(ws + WS_WOUT);
    bf16_t* XN = (bf16_t*)(ws + WS_XN); bf16_t* QA = (bf16_t*)(ws + WS_QA); bf16_t* QB = (bf16_t*)(ws + WS_QB); bf16_t* MIX = (bf16_t*)(ws + WS_MIX); bf16_t* Z = (bf16_t*)(ws + WS_Z);
    bf16_t* KA = (bf16_t*)(ws + WS_KA); bf16_t* VA = (bf16_t*)(ws + WS_VA); bf16_t* KB = (bf16_t*)(ws + WS_KB); bf16_t* VB = (bf16_t*)(ws + WS_VB); bf16_t* GA = (bf16_t*)(ws + WS_GA); bf16_t* GB = (bf16_t*)(ws + WS_GB);
    auto mk = [&](int p) { a.ph_lo = p; a.ph_hi = p + 1; a.li = p; hipLaunchKernelGGL(mk_fwd, dim3(grid), dim3(NWAVES * 64), LDS_BYTES, stream, a); };
    for (int l = 0; l < 2; ++l) {
        k_transpose<<<dim3(INC / 32, DM / 32), 256, 0, stream>>>(w_in + (size_t)l * DM * INC, WinN + (size_t)l * INC * DM, DM, INC);
        k_transpose<<<dim3(DM / 32, 512 / 32), 256, 0, stream>>>(w_oa + (size_t)l * 512 * DM, WoA + (size_t)l * DM * 512, 512, DM);
        k_transpose<<<dim3(DM / 32, 512 / 32), 256, 0, stream>>>(w_ob + (size_t)l * 512 * DM, WoB + (size_t)l * DM * 512, 512, DM);
        k_transpose<<<dim3(DM / 32, DM / 32), 256, 0, stream>>>(w_out + (size_t)l * DM * DM, Wout + (size_t)l * DM * DM, DM, DM);
    }
    if (OPT_MASK != 0) mk(0);
    if (!(OPT_MASK & 1)) { k_misc<<<256, 256, 0, stream>>>(rope, KA, VA, KB, VB, XN, Z, rowp); k_rownorm<<<NTOK / 4, 256, 0, stream>>>(x, meta, 1, norm_g, XN, rowp); }
    for (int l = 0; l < 2; ++l) {
        const int pb = 1 + 4 * l;
        if ((OPT_MASK >> pb) & 1) mk(pb);
        else { InArgs ia{XN, WinN + (size_t)l * INC * DM, rowp + (size_t)l * MPAD * 16, qng + l * 64, kng + l * 64, rope, QA, KA, VA, Z, QB, KB, VB, GA, GB}; k_inproj_naive<<<dim3(INC / 64, MPAD / 64), 256, 0, stream>>>(ia); }
        if ((OPT_MASK >> (pb + 1)) & 1) mk(pb + 1);
        else { k_gqa_naive<<<dim3(17, 8, NB), 256, 0, stream>>>(QA, KA, VA, Z); k_na_naive<<<dim3(65, 8, NB), 64, 0, stream>>>(QB, KB, VB, Z + 512, rpb + (size_t)l * 8 * 15 * 31); }
        if ((OPT_MASK >> (pb + 2)) & 1) mk(pb + 2);
        else k_mix_naive<<<dim3(DM / 64, MPAD / 64), 256, 0, stream>>>(Z, Z + 512, WoA + (size_t)l * DM * 512, WoB + (size_t)l * DM * 512, GA, GB, MIX);
        if ((OPT_MASK >> (pb + 3)) & 1) mk(pb + 3);
        else if (l == 0) { k_out_naive<<<dim3(DM / 64, MPAD / 64), 256, 0, stream>>>(MIX, Wout, x, meta, 1, out, HM); k_rownorm<<<NTOK / 4, 256, 0, stream>>>(out, HM, 0, norm_g + DM, XN, rowp + (size_t)MPAD * 16); }
        else { k_out_naive<<<dim3(DM / 64, MPAD / 64), 256, 0, stream>>>(MIX, Wout + (size_t)DM * DM, out, HM, 0, out, nullptr); k_rownorm<<<NTOK / 4, 256, 0, stream>>>(out, HM, 0, fin_g, XN, rowp + (size_t)2 * MPAD * 16); }
    }
    if ((OPT_MASK >> 9) & 1) mk(9); else k_final<<<NREAL / 4, 256, 0, stream>>>(out, fin_g);
}
```
